# Optimizing an MI355X kernel written in HIP

```python
import jax, jax.numpy as jnp
from jax import lax
import numpy as np

D_MODEL = 2048
BATCH = 2
SEQ = 8192
DEPTH = 2

GRID_W = 64
CTX_LEN = 256
N_MOD = 9
D_FF = 5632
CONV_DIM = D_MODEL // 2
CONV_WIDTH = 3
FOURIER_DIM = D_MODEL // 2
FOURIER_GROUPS = 8
FOURIER_GROUP_DIM = FOURIER_DIM // FOURIER_GROUPS
HEAD_DIM = 64
N_Q_HEADS = D_MODEL // HEAD_DIM
N_KV_HEADS = 4
KV_REP = N_Q_HEADS // N_KV_HEADS
WINDOW = 128
BLOCK = 128
ROPE_BASE = 10000.0
LN_EPS = 1e-5
NEG_INF = -1e30
ALPHA = (2 * DEPTH) ** 0.25
BETA = (8 * DEPTH) ** -0.25
N_EVEN = (DEPTH + 1) // 2
N_ODD = DEPTH // 2

kernel_name = "hybrid_conv_fourier_swa_dit_prefix"


def layer_norm(x, g, b):
    xf = x.astype(jnp.float32)
    mu = xf.mean(-1, keepdims=True)
    var = jnp.square(xf - mu).mean(-1, keepdims=True)
    y = (xf - mu) * lax.rsqrt(var + LN_EPS)
    return (y * g.astype(jnp.float32) + b.astype(jnp.float32)).astype(x.dtype)


def modulate(x, shift, scale):
    return x * (1 + scale) + shift


def post_norm_residual(x, y, gate, g, b):
    return layer_norm(ALPHA * x + gate * y, g, b)


def swiglu(h, wg, wu, wd):
    return (jax.nn.silu(h @ wg) * (h @ wu)) @ wd


def ffn_sublayer(x, shift, scale, gate, wg, wu, wd, g, b):
    y = swiglu(modulate(x, shift, scale), wg, wu, wd)
    return post_norm_residual(x, 0.5 * y, gate, g, b)


def conv_fourier_mixer(h, w_in, w_conv, w_out):
    bsz, seq_len, _ = h.shape
    u = h @ w_in
    g_b, g_c, x_in, u_f = jnp.split(u, [CONV_DIM, 2 * CONV_DIM, 3 * CONV_DIM], axis=-1)
    v = g_c * x_in
    pad = CONV_WIDTH // 2
    vp = jnp.pad(v, ((0, 0), (pad, pad), (0, 0)))
    conv = sum(w_conv[k] * vp[:, k:k + seq_len] for k in range(CONV_WIDTH))
    y_a = g_b * conv
    ug = u_f.astype(jnp.float32).reshape(bsz, seq_len, FOURIER_GROUPS, FOURIER_GROUP_DIM)
    y_b = jnp.fft.fft2(ug, axes=(1, 3), norm="ortho").real
    y_b = y_b.reshape(bsz, seq_len, FOURIER_DIM).astype(h.dtype)
    return jnp.concatenate([y_a, y_b], axis=-1) @ w_out


def axial_rope_tables(seq_len):
    rows = seq_len // GRID_W
    row = jnp.repeat(jnp.arange(rows, dtype=jnp.float32), GRID_W)
    col = jnp.tile(jnp.arange(GRID_W, dtype=jnp.float32), rows)
    n_freq = HEAD_DIM // 4
    inv_freq = jnp.power(ROPE_BASE, -jnp.arange(n_freq, dtype=jnp.float32) / n_freq)
    ang = jnp.concatenate([row[:, None] * inv_freq, col[:, None] * inv_freq], axis=-1)
    return jnp.cos(ang), jnp.sin(ang)


def apply_axial_rope(x, cos, sin):
    b, l, h, d = x.shape
    xa = x.reshape(b, l, h, 2, 2, d // 4)
    x1, x2 = xa[..., 0, :], xa[..., 1, :]
    c = cos.reshape(l, 1, 2, d // 4).astype(x.dtype)
    s = sin.reshape(l, 1, 2, d // 4).astype(x.dtype)
    out = jnp.stack([x1 * c - x2 * s, x2 * c + x1 * s], axis=-2)
    return out.reshape(b, l, h, d)


def attend(sink_g, scores, values):
    sink_col = jnp.broadcast_to(sink_g[None, :, :, None, None], scores[0].shape[:-1] + (1,))
    p = jax.nn.softmax(jnp.concatenate([sink_col] + scores, axis=-1), axis=-1)
    out = 0.0
    start = 1
    for s, v in zip(scores, values):
        n = s.shape[-1]
        out = out + jnp.einsum('bgrqk,bkgd->bqgrd', p[..., start:start + n].astype(v.dtype), v)
        start += n
    return out


def window_attention(h_lat, h_ctx, w_in, sink, w_out, cos, sin, need_ctx_out):
    bsz, seq_len, _ = h_lat.shape
    n_blk = seq_len // BLOCK
    scale = HEAD_DIM ** -0.5
    sink_g = sink.astype(jnp.float32).reshape(N_KV_HEADS, KV_REP)

    def project(h):
        b, n, _ = h.shape
        u = h @ w_in
        q, k, v = jnp.split(u, [N_Q_HEADS * HEAD_DIM, (N_Q_HEADS + N_KV_HEADS) * HEAD_DIM], axis=-1)
        return (q.reshape(b, n, N_Q_HEADS, HEAD_DIM), k.reshape(b, n, N_KV_HEADS, HEAD_DIM),
                v.reshape(b, n, N_KV_HEADS, HEAD_DIM))

    q_c, k_c, v_c = project(h_ctx)
    q_l, k_l, v_l = project(h_lat)
    q_l = apply_axial_rope(q_l, cos, sin)
    k_l = apply_axial_rope(k_l, cos, sin)

    qb = q_l.reshape(bsz, n_blk, BLOCK, N_KV_HEADS, KV_REP, HEAD_DIM).transpose(1, 0, 2, 3, 4, 5)

    def band(t):
        tp = jnp.pad(t, ((0, 0), (BLOCK, BLOCK), (0, 0), (0, 0)))
        tb = tp.reshape(bsz, n_blk + 2, BLOCK, N_KV_HEADS, HEAD_DIM)
        tband = jnp.concatenate([tb[:, :-2], tb[:, 1:-1], tb[:, 2:]], axis=2)
        return tband.transpose(1, 0, 2, 3, 4)

    k_band, v_band = band(k_l), band(v_l)
    blk = jnp.arange(n_blk)[:, None, None]
    a = jnp.arange(BLOCK)[None, :, None]
    j = jnp.arange(3 * BLOCK)[None, None, :]
    k_pos = blk * BLOCK + j - BLOCK
    mask = (jnp.abs(j - BLOCK - a) <= WINDOW) & (k_pos >= 0) & (k_pos < seq_len)

    def block_step(args):
        qi, ki, vi, mi = args
        s_ctx = jnp.einsum('bqgrd,bcgd->bgrqc', qi, k_c).astype(jnp.float32) * scale
        s_loc = jnp.einsum('bqgrd,bkgd->bgrqk', qi, ki).astype(jnp.float32) * scale
        s_loc = jnp.where(mi, s_loc, NEG_INF)
        return attend(sink_g, [s_ctx, s_loc], [v_c, vi])

    o = lax.map(block_step, (qb, k_band, v_band, mask))
    o = o.transpose(1, 0, 2, 3, 4, 5).reshape(bsz, seq_len, N_Q_HEADS * HEAD_DIM)
    y_lat = o @ w_out

    y_ctx = None
    if need_ctx_out:
        n_ctx = h_ctx.shape[1]
        qc = q_c.reshape(bsz, n_ctx, N_KV_HEADS, KV_REP, HEAD_DIM)
        s_cc = jnp.einsum('bqgrd,bcgd->bgrqc', qc, k_c).astype(jnp.float32) * scale
        oc = attend(sink_g, [s_cc], [v_c]).reshape(bsz, n_ctx, N_Q_HEADS * HEAD_DIM)
        y_ctx = oc @ w_out
    return y_lat, y_ctx


def setup_inputs(seed: int = 0) -> dict:
    key = jax.random.key(seed)
    ks = jax.random.split(key, 20)
    f32 = jnp.float32

    def nrm(k, shape, fan_in, gain=1.0):
        return jax.random.normal(k, shape, f32) * (gain * fan_in ** -0.5)

    qkv_w = (N_Q_HEADS + 2 * N_KV_HEADS) * HEAD_DIM
    return {
        "x": jax.random.normal(ks[0], (BATCH, SEQ, D_MODEL), f32),
        "c": jax.random.normal(ks[1], (BATCH, D_MODEL), f32),
        "ctx": jax.random.normal(ks[2], (BATCH, CTX_LEN, D_MODEL), f32),
        "c_ctx": jax.random.normal(ks[3], (D_MODEL,), f32),
        "w_mod": nrm(ks[4], (DEPTH, D_MODEL, N_MOD * D_MODEL), D_MODEL),
        "b_mod": 0.01 * jax.random.normal(ks[5], (DEPTH, N_MOD * D_MODEL), f32),
        "ln_g": 1.0 + 0.02 * jax.random.normal(ks[6], (DEPTH, 3, D_MODEL), f32),
        "ln_b": 0.02 * jax.random.normal(ks[7], (DEPTH, 3, D_MODEL), f32),
        "ffn_w_gate": nrm(ks[8], (DEPTH, 2, D_MODEL, D_FF), D_MODEL),
        "ffn_w_up": nrm(ks[9], (DEPTH, 2, D_MODEL, D_FF), D_MODEL),
        "ffn_w_down": nrm(ks[10], (DEPTH, 2, D_FF, D_MODEL), D_FF, BETA),
        "ab_w_in": nrm(ks[11], (N_EVEN, D_MODEL, 3 * CONV_DIM + FOURIER_DIM), D_MODEL),
        "ab_conv": nrm(ks[12], (N_EVEN, CONV_WIDTH, CONV_DIM), CONV_WIDTH),
        "ab_w_out": nrm(ks[13], (N_EVEN, CONV_DIM + FOURIER_DIM, D_MODEL), CONV_DIM + FOURIER_DIM, BETA),
        "attn_w_in": nrm(ks[14], (N_ODD, D_MODEL, qkv_w), D_MODEL),
        "attn_sink": jax.random.normal(ks[15], (N_ODD, N_Q_HEADS), f32),
        "attn_w_out": nrm(ks[16], (N_ODD, N_Q_HEADS * HEAD_DIM, D_MODEL), N_Q_HEADS * HEAD_DIM, BETA),
    }


def reference(x, c, ctx, c_ctx, w_mod, b_mod, ln_g, ln_b, ffn_w_gate, ffn_w_up, ffn_w_down,
              ab_w_in, ab_conv, ab_w_out, attn_w_in, attn_sink, attn_w_out):
    xl, xc = x, ctx
    cos, sin = axial_rope_tables(x.shape[1])
    for layer in range(DEPTH):
        last = layer == DEPTH - 1
        even = layer % 2 == 0
        idx = layer // 2
        ml = jnp.split((jax.nn.silu(c) @ w_mod[layer] + b_mod[layer])[:, None, :], N_MOD, axis=-1)
        mc = jnp.split((jax.nn.silu(c_ctx) @ w_mod[layer] + b_mod[layer])[None, None, :], N_MOD, axis=-1)
        ctx_ffn1 = not (last and even)
        ctx_rest = not last

        xl = ffn_sublayer(xl, ml[0], ml[1], ml[2], ffn_w_gate[layer, 0], ffn_w_up[layer, 0],
                          ffn_w_down[layer, 0], ln_g[layer, 0], ln_b[layer, 0])
        if ctx_ffn1:
            xc = ffn_sublayer(xc, mc[0], mc[1], mc[2], ffn_w_gate[layer, 0], ffn_w_up[layer, 0],
                              ffn_w_down[layer, 0], ln_g[layer, 0], ln_b[layer, 0])

        if even:
            yl = conv_fourier_mixer(modulate(xl, ml[3], ml[4]), ab_w_in[idx], ab_conv[idx], ab_w_out[idx])
            xl = post_norm_residual(xl, yl, ml[5], ln_g[layer, 1], ln_b[layer, 1])
            if ctx_rest:
                yc = conv_fourier_mixer(modulate(xc, mc[3], mc[4]), ab_w_in[idx], ab_conv[idx], ab_w_out[idx])
                xc = post_norm_residual(xc, yc, mc[5], ln_g[layer, 1], ln_b[layer, 1])
        else:
            yl, yc = window_attention(modulate(xl, ml[3], ml[4]), modulate(xc, mc[3], mc[4]),
                                      attn_w_in[idx], attn_sink[idx], attn_w_out[idx], cos, sin, ctx_rest)
            xl = post_norm_residual(xl, yl, ml[5], ln_g[layer, 1], ln_b[layer, 1])
            if ctx_rest:
                xc = post_norm_residual(xc, yc, mc[5], ln_g[layer, 1], ln_b[layer, 1])

        xl = ffn_sublayer(xl, ml[6], ml[7], ml[8], ffn_w_gate[layer, 1], ffn_w_up[layer, 1],
                          ffn_w_down[layer, 1], ln_g[layer, 2], ln_b[layer, 2])
        if ctx_rest:
            xc = ffn_sublayer(xc, mc[6], mc[7], mc[8], ffn_w_gate[layer, 1], ffn_w_up[layer, 1],
                              ffn_w_down[layer, 1], ln_g[layer, 2], ln_b[layer, 2])
    return xl
```

```cpp
#define PROBE 0
#include <hip/hip_runtime.h>
#include <cstdio>
#include <cstdint>

#define LAS __attribute__((address_space(3)))
#define GAS __attribute__((address_space(1)))
typedef unsigned short bf16_t;
typedef short bf16x8 __attribute__((ext_vector_type(8)));
typedef short s16x4 __attribute__((ext_vector_type(4)));
typedef float f32x4 __attribute__((ext_vector_type(4)));
typedef float f32x2 __attribute__((ext_vector_type(2)));
typedef float f32x16 __attribute__((ext_vector_type(16)));
typedef unsigned u32x4 __attribute__((ext_vector_type(4)));
typedef unsigned u32x2 __attribute__((ext_vector_type(2)));

constexpr int D = 2048, SEQ = 8192, CTXL = 256, FF = 5632, ML = 16384, MC = 512, MT = 16896, NMODC = 9 * 2048;
constexpr int NPL = ML / 256, NPT = MT / 256;
constexpr float ALPHA = 1.41421356237f, LN_EPS = 1e-5f, LOG2E = 1.4426950408889634f;
constexpr float QSCALE = 0.125f * 1.4426950408889634f;

constexpr size_t MiB = 1u << 20;
constexpr size_t WS_CTL = 0, CTL_ZERO_BYTES = 32 * 1024;
constexpr size_t WS_MOD = 1 * MiB;
constexpr size_t WS_ROPE = 2 * MiB;
constexpr size_t WS_ACTX = 3 * MiB;
constexpr size_t WS_A1 = 3 * MiB + 256 * 1024;

constexpr size_t WS_W1I = 4 * MiB;
constexpr size_t W1I_BYTES = (size_t)2 * FF * D * 2;
constexpr size_t WS_W2T = WS_W1I + 4 * W1I_BYTES;
constexpr size_t W2T_BYTES = (size_t)D * FF * 2;
constexpr size_t WS_WMI = WS_W2T + 4 * W2T_BYTES;
constexpr size_t WS_CH = WS_WMI + 16 * MiB;
constexpr size_t WS_WMO = WS_WMI + 20 * MiB;
constexpr size_t WS_WQKV = WS_WMO + 8 * MiB;
constexpr size_t WS_WO = WS_WQKV + 10 * MiB;
constexpr size_t WS_X = WS_WO + 8 * MiB;
constexpr size_t WS_XB = WS_X, WS_YB = WS_X + 64 * MiB, WS_XC = WS_X + 128 * MiB;
constexpr size_t WS_HB = WS_X + 132 * MiB;
constexpr size_t WS_GR = WS_HB + 66 * MiB;
constexpr size_t GR_GB = 0, GR_VB = 33 * MiB, GR_PTQ = 66 * MiB, GR_PTQC = 130 * MiB, GR_UF = 132 * MiB;
constexpr size_t GR_Q = 0, GR_KB = 64 * MiB, GR_VT = 73 * MiB;
constexpr size_t WS_T1 = WS_GR + 182 * MiB;
constexpr size_t WS_SLAB = WS_T1 + 64 * MiB;
constexpr size_t WS_A2M = WS_SLAB + 44 * MiB;
constexpr size_t WS_END = WS_A2M + 8 * MiB;
static_assert(WS_W2T == 180 * MiB && WS_X == 314 * MiB && WS_END == 810 * MiB, "ws map");
constexpr int CW_TMO = 0, CW_CODE = 1, CW_BAR = 4096;

#define RLX_AGENT __ATOMIC_RELAXED, __HIP_MEMORY_SCOPE_AGENT
#define LDS_WAIT() asm volatile("s_waitcnt lgkmcnt(0)" ::: "memory")
#define VM_WAIT() asm volatile("s_waitcnt vmcnt(0)" ::: "memory")
__device__ __forceinline__ unsigned cvt_pk_bf16(float lo, float hi) { unsigned r; asm volatile("v_cvt_pk_bf16_f32 %0, %1, %2" : "=v"(r) : "v"(lo), "v"(hi)); return r; }
__device__ __forceinline__ int vec_of_panel(int pm) { return pm < 32 ? 0 : (pm < 64 ? 1 : 2); }
__device__ __forceinline__ int tok_of_slot(int s) { return ((s >> 3) << 1) | ((s >> 2) & 1) | ((s & 3) << 6); }
__device__ __forceinline__ int slot_of_tok(int o) { return (((o >> 1) & 31) << 3) | ((o & 1) << 2) | (o >> 6); }
__device__ __forceinline__ int lds_img_byte(int r, int c) { const int st = (r >> 4) * 2 + (c >> 5), rr = r & 15, cc = c & 31, ob = rr * 64 + cc * 2; return st * 1024 + (ob ^ (((ob >> 9) & 1) << 5)); }
__device__ __forceinline__ size_t img_off(int row, int col, int K) { return (size_t)(row >> 8) * 256 * K + (size_t)(col >> 6) * 16384 + ((row >> 7) & 1) * 8192 + (lds_img_byte(row & 127, col & 63) >> 1); }
__device__ __forceinline__ size_t hb_off(int row, int col) { return img_off(row, col, 2048); }
__device__ __forceinline__ int vec_of_row(int r) { return r < SEQ ? 0 : (r < 2 * SEQ ? 1 : 2); }
__device__ __forceinline__ float silu_f(float g) { return g * __builtin_amdgcn_rcpf(1.f + __builtin_amdgcn_exp2f(-g * LOG2E)); }
__device__ __forceinline__ f32x4 silu_mul4(f32x4 g, f32x4 u) {
    const f32x4 t = g * (-LOG2E); f32x4 e;
    e[0] = __builtin_amdgcn_exp2f(t[0]); e[1] = __builtin_amdgcn_exp2f(t[1]); e[2] = __builtin_amdgcn_exp2f(t[2]); e[3] = __builtin_amdgcn_exp2f(t[3]);
    const f32x4 d = e + 1.f; f32x4 r;
    r[0] = __builtin_amdgcn_rcpf(d[0]); r[1] = __builtin_amdgcn_rcpf(d[1]); r[2] = __builtin_amdgcn_rcpf(d[2]); r[3] = __builtin_amdgcn_rcpf(d[3]);
    return (g * u) * r;
}

namespace pg8 {
#define PG8_LAS __attribute__((address_space(3)))
constexpr int BM = 256, BK = 64, HALF = 128, HTB = HALF * BK * 2  , STAGE_BYTES = 8 * HTB, NXCD = 8, WGM = 8;
__host__ __device__ __forceinline__ int lds_byte(int r, int c) { const int st = (r >> 4) * 2 + (c >> 5), rr = r & 15, cc = c & 31, ob = rr * 64 + cc * 2; return st * 1024 + (ob ^ (((ob >> 9) & 1) << 5)); }
__host__ __device__ __forceinline__ void stage_rc(int b, int& R, int& C) { const int st = b / 1024, sb = b % 1024, swz = sb ^ (((sb >> 9) & 1) << 5); R = (st >> 1) * 16 + swz / 64; C = (st & 1) * 32 + (swz % 64) / 2; }
__host__ __device__ __forceinline__ int perm32(int rho) { const int n = rho >> 4, i = rho & 15; return 8 * (i >> 2) + 4 * n + (i & 3); }

struct Unit { int pm, pn, am, bn, kind; };
struct Lay { int rs; unsigned kstep, hstep, hstepB; };
__device__ __forceinline__ Lay lay_rm(int ld) { Lay l; l.rs = ld; l.kstep = 128u; l.hstep = (unsigned)(HALF * ld * 2); l.hstepB = l.hstep; return l; }
__device__ __forceinline__ Lay lay_blk() { Lay l; l.rs = -1; l.kstep = 32768u; l.hstep = 16384u; l.hstepB = 16384u; return l; }
__host__ __device__ __forceinline__ void map_tile(int L, int nM, int nN, int& pm, int& pn) {
    const int nwg = nM * nN; int wgid = L; { const int q = nwg / NXCD, r = nwg % NXCD, xcd = wgid % NXCD, off = wgid / NXCD; wgid = (xcd < r ? xcd * (q + 1) : r * (q + 1) + (xcd - r) * q) + off; }
    const int nig = WGM * nN, gid = wgid / nig, fm = gid * WGM, gsz = (nM - fm) < WGM ? (nM - fm) : WGM;
    pm = fm + ((wgid % nig) % gsz); pn = (wgid % nig) / gsz;
}

__device__ __forceinline__ int opaque0() { int z = 0; asm volatile("" : "+s"(z)); return z; }
struct SchedBase {
    __device__ __forceinline__ int ktiles(const Unit&, int K) const { return K / BK; }
    __device__ __forceinline__ void a_ready(const Unit&) const {}
    __device__ __forceinline__ void done(const Unit&) const {}
};
struct SchedSimple : SchedBase {
    const char* A; const char* Bt; size_t tstep; int nM, nN, G, c;
    __device__ __forceinline__ bool next(int i, Unit& u) const {
        const int nwg = nM * nN, nfull = nwg / G; int ii = i;
        if (nfull >= 4 && i < nfull) { ii = i + ((c & 7) * 3) % nfull; if (ii >= nfull) ii -= nfull; }
        const long L = (long)ii * G + c; if (L >= (long)nwg) return false; map_tile((int)L, nM, nN, u.pm, u.pn); u.am = u.pm; u.bn = u.pn; u.kind = 0; return true; }
    __device__ __forceinline__ const char* a_ptr(const Unit& u) const { return A + (size_t)u.am * tstep; }
    __device__ __forceinline__ const char* b_ptr(const Unit& u) const { return Bt + (size_t)u.bn * tstep; }
};
template <size_t TSTEP, int NPARTS>
struct SchedRes : SchedBase {
    const char* A; const char* Bt; int G, c;
    __device__ __forceinline__ bool next(int i, Unit& u) const {
        if (i > 2 || (i == 2 && c >= 16 * NPARTS)) return false;
        const bool lat = i < 2; int pm, pn; map_tile((lat ? i : 0) * G + c, NPL, 8, pm, pn);
        u.kind = lat ? -1 : (c >> 4); u.pm = lat ? pm : NPL + ((c >> 3) & 1); u.pn = lat ? pn : (c & 7); u.am = u.pm; u.bn = u.pn; return true;
    }
    __device__ __forceinline__ int ktiles(const Unit& u, int K) const { return u.kind < 0 ? K / BK : 8; }
    __device__ __forceinline__ const char* a_ptr(const Unit& u) const { return A + (size_t)u.am * TSTEP + (u.kind < 0 ? (size_t)0 : (size_t)u.kind * (8 * 32768)); }
    __device__ __forceinline__ const char* b_ptr(const Unit& u) const { return Bt + (size_t)u.bn * TSTEP + (u.kind < 0 ? (size_t)0 : (size_t)u.kind * (8 * 32768)); }
};
struct SchedCh : SchedBase {
    const char* CH; const char* UF; int G, c;
    __device__ __forceinline__ bool next(int i, Unit& u) const {
        const long L = (long)i * G + c; if (L >= 512) return false;
        const int x = (int)L; u.am = x & 1; u.bn = (x >> 1) & 3; u.pn = (x >> 3) & 31; u.kind = x >> 8; u.pm = 2 * u.bn + u.am; return true;
    }
    __device__ __forceinline__ const char* a_ptr(const Unit& u) const { return CH + (size_t)u.am * ((size_t)256 * 1024 * 2); }
    __device__ __forceinline__ const char* b_ptr(const Unit& u) const { return UF + ((size_t)u.kind * SEQ + 8 * (u.pn >> 2) + 2048 * (u.pn & 3)) * 2048 + (size_t)u.bn * 512; }
};
struct SchedChC : SchedBase {
    const char* CH; const char* UF; int G, c;
    __device__ __forceinline__ bool next(int i, Unit& u) const {
        const long L = (long)i * G + c; if (L >= 16) return false;
        const int x = (int)L; u.am = (x >> 1) & 1; u.bn = x >> 2; u.pn = NPL + (x & 1); u.pm = 2 * u.bn + u.am; u.kind = 1; return true;
    }
    __device__ __forceinline__ const char* a_ptr(const Unit& u) const { return CH + (size_t)u.am * ((size_t)256 * 1024 * 2); }
    __device__ __forceinline__ const char* b_ptr(const Unit& u) const { return UF + (size_t)u.pn * ((size_t)256 * 1024 * 2) + (size_t)u.bn * 512; }
};
struct SchedAttnIn : SchedBase {
    const char* HB; const char* WQKV; size_t tstep; int G, c;
    __device__ __forceinline__ bool next(int i, Unit& u) const {
        const long L = (long)i * G + c;
        if (L < 576) { map_tile((int)L, 64, 9, u.pm, u.pn); u.kind = 0; }
        else if (L < 642) { u.pm = 0; u.pn = (int)L - 576; u.kind = 1; }
        else if (L < 644) { u.pm = 64 + ((int)L - 642); u.pn = 8; u.kind = 0; }
        else return false;
        u.am = u.pm; u.bn = u.pn; return true;
    }
    __device__ __forceinline__ const char* a_ptr(const Unit& u) const { return u.kind == 0 ? HB + (size_t)u.am * tstep : WQKV + (size_t)9 * tstep; }
    __device__ __forceinline__ const char* b_ptr(const Unit& u) const { return (u.kind == 0 ? WQKV : HB) + (size_t)u.bn * tstep; }
};
struct SchedF1 : SchedBase {
    const char* A1; const char* PT1; int G, c;
    __device__ __forceinline__ bool next(int i, Unit& u) const {
        const long L = (long)i * G + c; if (L >= 512) return false;
        u.kind = (int)L >> 8; u.pn = (int)L & 255; u.pm = 0; u.am = opaque0(); u.bn = u.pn; return true;
    }
    __device__ __forceinline__ const char* a_ptr(const Unit& u) const { return A1 + (size_t)u.am * 64; }
    __device__ __forceinline__ const char* b_ptr(const Unit& u) const { return PT1 + (size_t)u.kind * ((size_t)65536 * 256 * 2) + (size_t)u.bn * ((size_t)256 * 256 * 2); }
};
struct SchedF2 : SchedBase {
    const char* A2M; const char* T1; int G, c;
    __device__ __forceinline__ bool next(int i, Unit& u) const {
        const long L = (long)i * G + c; if (L >= 256) return false;
        u.kind = (int)L >> 7; u.am = ((int)L & 127) >> 2; u.bn = (int)L & 3; u.pm = 0; u.pn = u.bn; return true;
    }
    __device__ __forceinline__ const char* a_ptr(const Unit& u) const { return A2M + (size_t)u.am * ((size_t)256 * 512 * 2); }
    __device__ __forceinline__ const char* b_ptr(const Unit& u) const { return T1 + ((size_t)(u.kind * 32 + u.am) * 1024 + (size_t)u.bn * 256) * (512 * 2); }
};
struct SchedDftC : SchedBase {
    const char* ACTX; const char* PTQC; size_t tstep; int G, c;
    __device__ __forceinline__ bool next(int i, Unit& u) const {
        const long L = (long)i * G + c; if (L >= 8) return false;
        u.kind = (int)L >> 2; u.am = opaque0(); u.bn = (int)L & 3; u.pm = 64 + u.kind; u.pn = u.bn; return true;
    }
    __device__ __forceinline__ const char* a_ptr(const Unit& u) const { return ACTX + (size_t)u.am * 64; }
    __device__ __forceinline__ const char* b_ptr(const Unit& u) const { return PTQC + (size_t)u.kind * ((size_t)2048 * 256 * 2) + (size_t)u.bn * tstep; }
};

typedef f32x4 AccT[2][2][4][2];

struct EpiSwiglu {
    static constexpr bool PERM = true, AFTER_DRAIN = false; static constexpr int BMAP = 0;
    bf16_t* G;
    __device__ __forceinline__ void operator()(const AccT& acc, const Unit& u, int wr, int wc, int fr, int fq) const {
        const int rr0 = wr * 64 + fr, col0 = u.pn * 128 + wc * 32 + 8 * fq;
        const int grow0 = u.pm * BM + rr0;
#pragma unroll
        for (int ai = 0; ai < 2; ++ai)
#pragma unroll
            for (int m = 0; m < 4; ++m) {
                bf16_t* rowp = G + img_off(grow0 + ai * HALF + m * 16, col0, FF);
                const f32x4 g0 = acc[ai][0][m][0], g1 = acc[ai][0][m][1], u0 = acc[ai][1][m][0], u1 = acc[ai][1][m][1];
                const f32x4 v0 = silu_mul4(g0, u0), v1 = silu_mul4(g1, u1);
                u32x4 w; w.x = cvt_pk_bf16(v0[0], v0[1]); w.y = cvt_pk_bf16(v0[2], v0[3]); w.z = cvt_pk_bf16(v1[0], v1[1]); w.w = cvt_pk_bf16(v1[2], v1[3]);
                *(u32x4*)rowp = w;
            }
    }
};
struct EpiY {
    static constexpr bool PERM = true, AFTER_DRAIN = false; static constexpr int BMAP = 0;
    bf16_t* YB; const float* gate; float ysc;
    bf16_t* YC;
    __device__ __forceinline__ void operator()(const AccT& acc, const Unit& u, int wr, int wc, int fr, int fq) const {
        const int row0 = u.pm * BM + wr * 64 + fr, col0 = u.pn * BM + wc * 32 + 8 * fq;
        const float* gp = gate + (size_t)vec_of_panel(u.pm) * NMODC + col0;
        bf16_t* ybase = u.kind < 0 ? YB : YC + ((size_t)u.kind * MC - ML) * D;
        f32x4 gv[2][2];
#pragma unroll
        for (int bj = 0; bj < 2; ++bj)
#pragma unroll
            for (int n = 0; n < 2; ++n) gv[bj][n] = *(const f32x4*)(gp + bj * HALF + n * 4) * ysc;
#pragma unroll
        for (int ai = 0; ai < 2; ++ai)
#pragma unroll
            for (int m = 0; m < 4; ++m) {
                bf16_t* rowp = ybase + (size_t)(row0 + ai * HALF + m * 16) * D + col0;
#pragma unroll
                for (int bj = 0; bj < 2; ++bj) {
                    const f32x4 v0 = acc[ai][bj][m][0] * gv[bj][0], v1 = acc[ai][bj][m][1] * gv[bj][1];
                    u32x4 w; w.x = cvt_pk_bf16(v0[0], v0[1]); w.y = cvt_pk_bf16(v0[2], v0[3]); w.z = cvt_pk_bf16(v1[0], v1[1]); w.w = cvt_pk_bf16(v1[2], v1[3]);
                    *(u32x4*)(rowp + bj * HALF) = w;
                }
            }
    }
};
struct EpiMixIn {
    static constexpr bool PERM = true, AFTER_DRAIN = false; static constexpr int BMAP = 0;
    bf16_t* GB; bf16_t* VB; bf16_t* UF;
    __device__ __forceinline__ void operator()(const AccT& acc, const Unit& u, int wr, int wc, int fr, int fq) const {
        const int rs0 = wr * 64 + fr, cl = wc * 32 + 8 * fq;
#pragma unroll
        for (int ai = 0; ai < 2; ++ai)
#pragma unroll
            for (int m = 0; m < 4; ++m) {
                const int rs = rs0 + ai * HALF + m * 16; const size_t row = (size_t)u.pm * BM + rs;
                if (u.pn >= 4 && u.pn < 12) {
                    const f32x4 v0 = acc[ai][0][m][0] * acc[ai][1][m][0], v1 = acc[ai][0][m][1] * acc[ai][1][m][1];
                    u32x4 w; w.x = cvt_pk_bf16(v0[0], v0[1]); w.y = cvt_pk_bf16(v0[2], v0[3]); w.z = cvt_pk_bf16(v1[0], v1[1]); w.w = cvt_pk_bf16(v1[2], v1[3]);
                    *(u32x4*)(VB + row * 1024 + (u.pn - 4) * 128 + cl) = w;
                } else {
                    bf16_t* dst = u.pn < 4 ? GB + row * 1024 + u.pn * 256 + cl : UF + row * 1024 + (u.pn - 12) * 256 + cl;
#pragma unroll
                    for (int bj = 0; bj < 2; ++bj) {
                        const f32x4 v0 = acc[ai][bj][m][0], v1 = acc[ai][bj][m][1];
                        u32x4 w; w.x = cvt_pk_bf16(v0[0], v0[1]); w.y = cvt_pk_bf16(v0[2], v0[3]); w.z = cvt_pk_bf16(v1[0], v1[1]); w.w = cvt_pk_bf16(v1[2], v1[3]);
                        *(u32x4*)(dst + bj * HALF) = w;
                    }
                }
            }
    }
};
struct EpiCh {
    static constexpr bool PERM = true, AFTER_DRAIN = false; static constexpr int BMAP = 1;
    bf16_t* PT1;
    __device__ __forceinline__ void operator()(const AccT& acc, const Unit& u, int wr, int wc, int fr, int fq) const {
        const int rs0 = wr * 64 + fr, q = u.pn >> 2, r = u.pn & 3;
        bf16_t* base = PT1 + (size_t)u.kind * ((size_t)65536 * 256) + 32 * r + 8 * fq;
#pragma unroll
        for (int ai = 0; ai < 2; ++ai)
#pragma unroll
            for (int m = 0; m < 4; ++m) {
                const int w = u.pm * BM + rs0 + ai * HALF + m * 16, col = w >> 1, s = w & 1;
#pragma unroll
                for (int bj = 0; bj < 2; ++bj) {
                    const int n1 = 8 * q + 4 * bj + wc; const f32x4 v0 = acc[ai][bj][m][0], v1 = acc[ai][bj][m][1];
                    u32x4 pk; pk.x = cvt_pk_bf16(v0[0], v0[1]); pk.y = cvt_pk_bf16(v0[2], v0[3]); pk.z = cvt_pk_bf16(v1[0], v1[1]); pk.w = cvt_pk_bf16(v1[2], v1[3]);
                    *(u32x4*)(base + ((size_t)(col * 64 + n1) * 2 + s) * 128) = pk;
                }
            }
    }
};
struct EpiChC {
    static constexpr bool PERM = true, AFTER_DRAIN = false; static constexpr int BMAP = 0;
    bf16_t* PTQC;
    __device__ __forceinline__ void operator()(const AccT& acc, const Unit& u, int wr, int wc, int fr, int fq) const {
        const int rs0 = wr * 64 + fr, cl = wc * 32 + 8 * fq;
        bf16_t* base = PTQC + (size_t)(u.pn - NPL) * ((size_t)2048 * 256);
#pragma unroll
        for (int ai = 0; ai < 2; ++ai)
#pragma unroll
            for (int m = 0; m < 4; ++m) {
                bf16_t* rowp = base + (size_t)(u.pm * BM + rs0 + ai * HALF + m * 16) * 256 + cl;
#pragma unroll
                for (int bj = 0; bj < 2; ++bj) {
                    const f32x4 v0 = acc[ai][bj][m][0], v1 = acc[ai][bj][m][1];
                    u32x4 w; w.x = cvt_pk_bf16(v0[0], v0[1]); w.y = cvt_pk_bf16(v0[2], v0[3]); w.z = cvt_pk_bf16(v1[0], v1[1]); w.w = cvt_pk_bf16(v1[2], v1[3]);
                    *(u32x4*)(rowp + bj * HALF) = w;
                }
            }
    }
};
struct EpiF1 {
    static constexpr bool PERM = true, AFTER_DRAIN = false; static constexpr int BMAP = 0;
    bf16_t* T1;
    __device__ __forceinline__ void operator()(const AccT& acc, const Unit& u, int wr, int wc, int fr, int fq) const {
        const int n10 = 32 * (wc & 1) + 8 * fq + u.am;
#pragma unroll
        for (int ai = 0; ai < 2; ++ai)
#pragma unroll
            for (int m = 0; m < 4; ++m) {
                const int k2 = wr * 64 + m * 16 + fr + u.am;
#pragma unroll
                for (int bj = 0; bj < 2; ++bj) {
                    const int col = 4 * u.pn + 2 * bj + (wc >> 1);
                    const f32x4 v0 = acc[ai][bj][m][0], v1 = acc[ai][bj][m][1];
                    u32x4 w; w.x = cvt_pk_bf16(v0[0], v0[1]); w.y = cvt_pk_bf16(v0[2], v0[3]); w.z = cvt_pk_bf16(v1[0], v1[1]); w.w = cvt_pk_bf16(v1[2], v1[3]);
                    *(u32x4*)(T1 + (((((size_t)u.kind * 32 + (k2 >> 2)) * 1024 + col) * 4 + (k2 & 3)) * 2 + ai) * 64 + n10) = w;
                }
            }
    }
};
struct EpiF2 {
    static constexpr bool PERM = true, AFTER_DRAIN = false; static constexpr int BMAP = 0;
    bf16_t* A2; float norm;
    __device__ __forceinline__ void operator()(const AccT& acc, const Unit& u, int wr, int wc, int fr, int fq) const {
        const int col0 = 1024 + u.bn * 256 + wc * 32 + 8 * fq;
#pragma unroll
        for (int ai = 0; ai < 2; ++ai)
#pragma unroll
            for (int m = 0; m < 4; ++m) {
                const int k = 4 * u.am + 2 * ai + wr + 128 * (16 * m + fr);
                bf16_t* rowp = A2 + hb_off(u.kind * SEQ + k, col0);
#pragma unroll
                for (int bj = 0; bj < 2; ++bj) {
                    const f32x4 v0 = acc[ai][bj][m][0] * norm, v1 = acc[ai][bj][m][1] * norm;
                    u32x4 w; w.x = cvt_pk_bf16(v0[0], v0[1]); w.y = cvt_pk_bf16(v0[2], v0[3]); w.z = cvt_pk_bf16(v1[0], v1[1]); w.w = cvt_pk_bf16(v1[2], v1[3]);
                    *(u32x4*)(rowp + bj * 2 * 16384) = w;
                }
            }
    }
};
struct EpiDft {
    static constexpr bool PERM = true, AFTER_DRAIN = false; static constexpr int BMAP = 0;
    bf16_t* A2; float norm;
    __device__ __forceinline__ void operator()(const AccT& acc, const Unit& u, int wr, int wc, int fr, int fq) const {
        const int row0 = u.pm * BM + wr * 64 + fr, col0 = 1024 + u.pn * 256 + wc * 32 + 8 * fq;
#pragma unroll
        for (int ai = 0; ai < 2; ++ai)
#pragma unroll
            for (int m = 0; m < 4; ++m) {
                bf16_t* rowp = A2 + hb_off(row0 + ai * HALF + m * 16, col0);
#pragma unroll
                for (int bj = 0; bj < 2; ++bj) {
                    const f32x4 v0 = acc[ai][bj][m][0] * norm, v1 = acc[ai][bj][m][1] * norm;
                    u32x4 w; w.x = cvt_pk_bf16(v0[0], v0[1]); w.y = cvt_pk_bf16(v0[2], v0[3]); w.z = cvt_pk_bf16(v1[0], v1[1]); w.w = cvt_pk_bf16(v1[2], v1[3]);
                    *(u32x4*)(rowp + bj * 2 * 16384) = w;
                }
            }
    }
};
struct EpiAttnIn {
    static constexpr bool PERM = false, AFTER_DRAIN = false; static constexpr int BMAP = 0;
    bf16_t* Q; bf16_t* KB; bf16_t* VT; const float* ropec; const float* ropes;
    __device__ __forceinline__ void operator()(const AccT& acc, const Unit& u, int wr, int wc, int fr, int fq) const {
        const int row0 = u.pm * BM + wr * 64 + fr, cl = wc * 32 + 4 * fq, cq = wc * 32 + 8 * fq;
        if (u.kind == 1) {
#pragma unroll
            for (int ai = 0; ai < 2; ++ai)
#pragma unroll
                for (int m = 0; m < 4; ++m) {
                    bf16_t* rowp = VT + (size_t)(wr * 64 + fr + ai * HALF + m * 16) * MT + u.pn * 256 + wc * 32 + 4 * (((fq & 1) << 1) | (fq >> 1));
#pragma unroll
                    for (int bj = 0; bj < 2; ++bj)
#pragma unroll
                        for (int n = 0; n < 2; ++n) { const f32x4 v = acc[ai][bj][m][n]; u32x2 w; w.x = cvt_pk_bf16(v[0], v[1]); w.y = cvt_pk_bf16(v[2], v[3]); *(u32x2*)(rowp + bj * HALF + n * 16) = w; }
                }
            return;
        }
        const bool isq = u.pn < 8, rope = u.pm < NPL;
        const float sc = isq ? QSCALE : 1.f;
        bf16_t* base = isq ? Q + u.pn * 256 : KB; const size_t ldc = isq ? 2048 : 256;
#pragma unroll
        for (int ai = 0; ai < 2; ++ai)
#pragma unroll
            for (int m = 0; m < 4; ++m) {
                const int r = row0 + ai * HALF + m * 16, pos = r & (SEQ - 1);
                const int p = (wc & 1) ? (pos & 63) : (pos >> 6);
                f32x4 cs = (f32x4){1.f, 1.f, 1.f, 1.f}, sn = (f32x4){0.f, 0.f, 0.f, 0.f};
                if (rope) { cs = *(const f32x4*)(ropec + p * 16 + 4 * fq); sn = *(const f32x4*)(ropes + p * 16 + 4 * fq); }
                bf16_t* rowp = base + (size_t)r * ldc + cq;
#pragma unroll
                for (int bj = 0; bj < 2; ++bj) {
                    const f32x4 x1 = acc[ai][bj][m][0], x2 = acc[ai][bj][m][1];
                    const f32x4 o1 = (x1 * cs - x2 * sn) * sc, o2 = (x2 * cs + x1 * sn) * sc;
                    u32x4 w; w.x = cvt_pk_bf16(o1[0], o1[1]); w.y = cvt_pk_bf16(o1[2], o1[3]); w.z = cvt_pk_bf16(o2[0], o2[1]); w.w = cvt_pk_bf16(o2[2], o2[3]);
                    *(u32x4*)(rowp + bj * HALF) = w;
                }
            }
    }
};

template <class Epi, class Sched, bool ALIGN_EPI = false, bool SP2 = false>
__device__ __forceinline__ void gemm_phase(PG8_LAS unsigned char* lds, const int K, const Lay lay, const Sched& S, const Epi& E) {
    const int tid = threadIdx.x, wid = __builtin_amdgcn_readfirstlane(tid >> 6), lane = tid & 63, wr = wid >> 2, wc = wid & 3, fr = lane & 15, fq = lane >> 4;

    unsigned voffA[2], voffB[2];
#pragma unroll
    for (int i = 0; i < 2; ++i) { int R, C; stage_rc(tid * 16 + i * 8192, R, C); const int Rb = Epi::BMAP == 1 ? ((R >> 5) + 64 * perm32(R & 31)) : (Epi::PERM ? ((R & ~31) + perm32(R & 31)) : R);
        if (lay.rs < 0) { voffA[i] = voffB[i] = (unsigned)(tid * 16 + i * 8192); } else { voffA[i] = (unsigned)(R * lay.rs + C) * 2u; voffB[i] = (unsigned)(Rb * lay.rs + C) * 2u; }     }
    const size_t kstep = lay.kstep; const size_t hstepB = lay.hstepB;
    const size_t hstep = lay.hstep;
    const unsigned ldsw = (unsigned)wid * 1024u;
    const int aoff = lds_byte(wr * 64 + fr, fq * 8), boff = lds_byte(wc * 32 + fr, fq * 8);
#define PG8_SA(b, h) (((b) * 2 + (h)) * HTB)
#define PG8_SB(b, h) ((4 + (b) * 2 + (h)) * HTB)
#define PG8_STAGE(bufoff, gbase, voff) do { _Pragma("unroll") for (int _i = 0; _i < 2; ++_i) \
        __builtin_amdgcn_global_load_lds((const unsigned*)((const char*)(gbase) + (voff)[_i]), (PG8_LAS unsigned*)(lds + (bufoff) + ldsw + _i * 8192), 16, 0, 0); } while (0)
#define PG8_LDA(dst, b, h) do { _Pragma("unroll") for (int m = 0; m < 4; ++m) _Pragma("unroll") for (int k = 0; k < 2; ++k) dst[m][k] = *(const PG8_LAS bf16x8*)(lds + PG8_SA(b, h) + aoff + m * 2048 + k * 1024); } while (0)
#define PG8_LDB(dst, b, h) do { _Pragma("unroll") for (int n = 0; n < 2; ++n) _Pragma("unroll") for (int k = 0; k < 2; ++k) dst[n][k] = *(const PG8_LAS bf16x8*)(lds + PG8_SB(b, h) + boff + n * 2048 + k * 1024); } while (0)
#define PG8_MMA(ai, bj, At, Bt) do { __builtin_amdgcn_s_setprio(1); _Pragma("unroll") for (int m = 0; m < 4; ++m) _Pragma("unroll") for (int n = 0; n < 2; ++n) _Pragma("unroll") for (int k = 0; k < 2; ++k) \
        acc[ai][bj][m][n] = __builtin_amdgcn_mfma_f32_16x16x32_bf16(Bt[n][k], At[m][k], acc[ai][bj][m][n], 0, 0, 0); __builtin_amdgcn_s_setprio(0); } while (0)
#define PG8_WAIT_V(n) asm volatile("s_waitcnt vmcnt(" #n ")" ::: "memory")
#define PG8_WAIT_L(n) asm volatile("s_waitcnt lgkmcnt(" #n ")" ::: "memory")
#define PG8_BAR __builtin_amdgcn_s_barrier()
#define PG8_SCHED __builtin_amdgcn_sched_barrier(0)
    Unit cur, nxt; int ui = 0;
    if (!S.next(0, cur)) return;
    int nt = S.ktiles(cur, K);
    AccT acc;
#pragma unroll
    for (int a = 0; a < 2; ++a)
#pragma unroll
        for (int b = 0; b < 2; ++b)
#pragma unroll
            for (int m = 0; m < 4; ++m)
#pragma unroll
                for (int n = 0; n < 2; ++n) acc[a][b][m][n] = (f32x4){0.f, 0.f, 0.f, 0.f};
    bf16x8 At[4][2], B0[2][2], B1[2][2];
    const char* cA = S.a_ptr(cur); const char* cB = S.b_ptr(cur);
    S.a_ready(cur);
    if constexpr (SP2) {
        PG8_STAGE(PG8_SB(0, 0), cB, voffB); PG8_STAGE(PG8_SB(0, 1), cB + hstepB, voffB); PG8_STAGE(PG8_SA(0, 0), cA, voffA); PG8_STAGE(PG8_SA(0, 1), cA + hstep, voffA);
        if (wr == 1) PG8_BAR;
        PG8_WAIT_V(2); PG8_BAR;
        PG8_STAGE(PG8_SB(1, 0), cB + kstep, voffB); PG8_STAGE(PG8_SA(1, 0), cA + kstep, voffA); PG8_STAGE(PG8_SB(1, 1), cB + hstepB + kstep, voffB);
        PG8_WAIT_V(6); PG8_BAR;
    } else {
        PG8_STAGE(PG8_SB(0, 0), cB, voffB); PG8_STAGE(PG8_SA(0, 0), cA, voffA); PG8_STAGE(PG8_SB(0, 1), cB + hstepB, voffB); PG8_STAGE(PG8_SA(0, 1), cA + hstep, voffA);
        if (wr == 1) PG8_BAR;
        PG8_WAIT_V(4); PG8_BAR;
        PG8_STAGE(PG8_SB(1, 0), cB + kstep, voffB); PG8_STAGE(PG8_SA(1, 0), cA + kstep, voffA); PG8_STAGE(PG8_SB(1, 1), cB + hstepB + kstep, voffB);
        PG8_WAIT_V(6); PG8_BAR;
    }
    for (;;) {
        const bool has_next = S.next(ui + 1, nxt);
        const char* nA = has_next ? S.a_ptr(nxt) : cA; const char* nB = has_next ? S.b_ptr(nxt) : cB;
        for (int t = 0; t < nt; t += 2) {
            const bool last = (t == nt - 2);
            const char* a1 = cA + (size_t)(t + 1) * kstep;
            const char* a2 = last ? nA : cA + (size_t)(t + 2) * kstep; const char* b2 = last ? nB : cB + (size_t)(t + 2) * kstep;
            const char* a3 = a2 + kstep; const char* b3 = b2 + kstep;
            if (last && has_next) S.a_ready(nxt);
            if constexpr (SP2) {
            PG8_LDB(B0, 0, 0); PG8_LDB(B1, 0, 1); PG8_SCHED; PG8_LDA(At, 0, 0); PG8_STAGE(PG8_SA(1, 1), a1 + hstep, voffA);
            PG8_WAIT_V(8); PG8_WAIT_L(0); PG8_BAR; PG8_MMA(0, 0, At, B0); PG8_MMA(0, 1, At, B1); PG8_BAR; PG8_SCHED;
            PG8_LDA(At, 0, 1); PG8_STAGE(PG8_SB(0, 0), b2, voffB); PG8_STAGE(PG8_SB(0, 1), b2 + hstepB, voffB); PG8_STAGE(PG8_SA(0, 0), a2, voffA);
            PG8_WAIT_V(8); PG8_WAIT_L(0); PG8_BAR; PG8_MMA(1, 0, At, B0); PG8_MMA(1, 1, At, B1); PG8_BAR; PG8_SCHED;
            PG8_LDB(B0, 1, 0); PG8_LDB(B1, 1, 1); PG8_SCHED; PG8_LDA(At, 1, 0); PG8_STAGE(PG8_SA(0, 1), a2 + hstep, voffA);
            PG8_WAIT_V(8); PG8_WAIT_L(0); PG8_BAR; PG8_MMA(0, 0, At, B0); PG8_MMA(0, 1, At, B1); PG8_BAR; PG8_SCHED;
            PG8_LDA(At, 1, 1); PG8_STAGE(PG8_SB(1, 0), b3, voffB); PG8_STAGE(PG8_SB(1, 1), b3 + hstepB, voffB); PG8_STAGE(PG8_SA(1, 0), a3, voffA);
            PG8_WAIT_V(8); PG8_WAIT_L(0); PG8_BAR; PG8_MMA(1, 0, At, B0); PG8_MMA(1, 1, At, B1); PG8_BAR; PG8_SCHED;
            } else {
            PG8_LDB(B0, 0, 0); PG8_SCHED; PG8_LDA(At, 0, 0); PG8_STAGE(PG8_SA(1, 1), a1 + hstep, voffA);
            PG8_WAIT_L(8); PG8_BAR; PG8_WAIT_L(0); PG8_MMA(0, 0, At, B0); PG8_BAR; PG8_SCHED;
            PG8_LDB(B1, 0, 1); PG8_STAGE(PG8_SB(0, 0), b2, voffB);
            PG8_BAR; PG8_WAIT_L(0); PG8_MMA(0, 1, At, B1); PG8_BAR;
            PG8_LDA(At, 0, 1); PG8_STAGE(PG8_SA(0, 0), a2, voffA);
            PG8_BAR; PG8_WAIT_L(0); PG8_MMA(1, 0, At, B0); PG8_BAR; PG8_SCHED;
            PG8_STAGE(PG8_SB(0, 1), b2 + hstepB, voffB);
            PG8_WAIT_V(6); PG8_BAR; PG8_MMA(1, 1, At, B1); PG8_BAR;
            PG8_LDB(B0, 1, 0); PG8_SCHED; PG8_LDA(At, 1, 0); PG8_STAGE(PG8_SA(0, 1), a2 + hstep, voffA);
            PG8_WAIT_L(8); PG8_BAR; PG8_WAIT_L(0); PG8_MMA(0, 0, At, B0); PG8_BAR; PG8_SCHED;
            PG8_LDB(B1, 1, 1); PG8_STAGE(PG8_SB(1, 0), b3, voffB);
            PG8_BAR; PG8_WAIT_L(0); PG8_MMA(0, 1, At, B1); PG8_BAR;
            PG8_LDA(At, 1, 1); PG8_STAGE(PG8_SA(1, 0), a3, voffA);
            PG8_BAR; PG8_WAIT_L(0); PG8_MMA(1, 0, At, B0); PG8_BAR; PG8_SCHED;
            PG8_STAGE(PG8_SB(1, 1), b3 + hstepB, voffB);
            PG8_WAIT_V(6); PG8_BAR; PG8_MMA(1, 1, At, B1); PG8_BAR;
            }
        }
        if constexpr (ALIGN_EPI) { if (wr == 0) PG8_BAR; }
        if constexpr (!Epi::AFTER_DRAIN) { E(acc, cur, wr, wc, fr, fq); S.done(cur); }
        if (!has_next) break;
#pragma unroll
        for (int a = 0; a < 2; ++a)
#pragma unroll
            for (int b = 0; b < 2; ++b)
#pragma unroll
                for (int m = 0; m < 4; ++m)
#pragma unroll
                    for (int n = 0; n < 2; ++n) acc[a][b][m][n] = (f32x4){0.f, 0.f, 0.f, 0.f};
        cur = nxt; cA = nA; cB = nB; ++ui; nt = S.ktiles(cur, K);
        if constexpr (ALIGN_EPI) { if (wr == 1) PG8_BAR; }
    }
    PG8_WAIT_V(0);
    if constexpr (!ALIGN_EPI) { if (wr == 0) PG8_BAR; }
    PG8_BAR;
    if constexpr (Epi::AFTER_DRAIN) { E.fused(acc, cur, wr, wc, fr, fq, lds, wid, lane); S.done(cur); }
#undef PG8_SA
#undef PG8_SB
#undef PG8_STAGE
#undef PG8_LDA
#undef PG8_LDB
#undef PG8_MMA
#undef PG8_WAIT_V
#undef PG8_WAIT_L
#undef PG8_BAR
#undef PG8_SCHED
}
}

#define XB_TMO      128
#define XB_XCNT(j)  (256  + 64 * (j))
#define XB_XSUB(j)  (1280 + 64 * (j))
#define XB_XGEN(j)  (2304 + 64 * (j))
#define XB_TOP      3328
#define XB_TOPGEN   3392
#define XCD_BAR_WORDS 3456
#define XB_SPIN_CAP (1u << 18)

__device__ __forceinline__ unsigned xb_ld(unsigned* p)              { return __hip_atomic_load(p, __ATOMIC_RELAXED, __HIP_MEMORY_SCOPE_AGENT); }
__device__ __forceinline__ unsigned xb_add(unsigned* p, unsigned v) { return __hip_atomic_fetch_add(p, v, __ATOMIC_RELAXED, __HIP_MEMORY_SCOPE_AGENT); }
__device__ __forceinline__ unsigned xb_xcc_id() { return (unsigned)__builtin_amdgcn_s_getreg((3 << 11) | 20) & 0xFu; }
#define XB_SPIN(cond, bar) do { unsigned _sp = 0; while (cond) { __builtin_amdgcn_s_sleep(1); \
    if ((++_sp & 255u) == 0u) { if (xb_ld(&(bar)[XB_TMO])) break; if (_sp > XB_SPIN_CAP) { atomicAdd(&(bar)[XB_TMO], 1u); break; } } } } while (0)

struct XcdBarrier {
    unsigned* bar; unsigned x;
    volatile LAS unsigned* st;
};

__device__ __forceinline__ XcdBarrier xcd_barrier_post(unsigned* bar, volatile LAS unsigned* st) {
    XcdBarrier b; b.bar = bar; b.x = xb_xcc_id(); b.st = st;
    if (threadIdx.x == 0) (void)xb_add(&bar[XB_XCNT(b.x)], 1u);
    return b;
}
__device__ __forceinline__ void xcd_barrier_complete(unsigned* bar, unsigned x, unsigned& nloc, unsigned& nx) {
    const unsigned G = gridDim.x * gridDim.y * gridDim.z;
    unsigned sum, cnt, mine, sp = 0u;
    for (;;) {
        sum = 0u; cnt = 0u; mine = 0u;
#pragma unroll
        for (unsigned j = 0; j < 16; ++j) { const unsigned c = xb_ld(&bar[XB_XCNT(j)]); sum += c; cnt += (c > 0u) ? 1u : 0u; mine = (j == x) ? c : mine; }
        if (sum == G) break;
        __builtin_amdgcn_s_sleep(1);
        if ((++sp & 255u) == 0u) { if (xb_ld(&bar[XB_TMO])) break; if (sp > XB_SPIN_CAP) { atomicAdd(&bar[XB_TMO], 1u); break; } }
    }
    nloc = mine > 0u ? mine : 1u; nx = cnt > 0u ? cnt : 1u;
}

__device__ __forceinline__ void xcd_barrier(const XcdBarrier& b) {
    asm volatile("s_waitcnt vmcnt(0)" ::: "memory");
    __syncthreads();
    if (threadIdx.x == 0) {
        unsigned* bar = b.bar;
        __builtin_amdgcn_s_waitcnt(0);
        unsigned nloc = b.st[0], nx = b.st[1];
        if (nloc == 0u) { xcd_barrier_complete(bar, b.x, nloc, nx); b.st[0] = nloc; b.st[1] = nx; }
        const unsigned old = xb_add(&bar[XB_XSUB(b.x)], 1u);
        const unsigned gen = old / nloc;
        if (old + 1u == (gen + 1u) * nloc) {
            __builtin_amdgcn_fence(__ATOMIC_RELEASE, "agent");
            asm volatile("s_waitcnt vmcnt(0)" ::: "memory");
            const unsigned og = xb_add(&bar[XB_TOP], 1u);
            const unsigned tg = og / nx;
            if (og + 1u == (tg + 1u) * nx) xb_add(&bar[XB_TOPGEN], 1u);
            else XB_SPIN(xb_ld(&bar[XB_TOPGEN]) == tg, bar);
            __builtin_amdgcn_fence(__ATOMIC_ACQUIRE, "agent");
            xb_add(&bar[XB_XGEN(b.x)], 1u);
            asm volatile("s_waitcnt vmcnt(0)" ::: "memory");
        } else {
            XB_SPIN(xb_ld(&bar[XB_XGEN(b.x)]) == gen, bar);
            __builtin_amdgcn_fence(__ATOMIC_ACQUIRE, "agent");
            asm volatile("s_waitcnt vmcnt(0)" ::: "memory");
        }
    }
    __syncthreads();
}

__device__ __forceinline__ float wave_sum(float v) {
#pragma unroll
    for (int o = 1; o < 64; o <<= 1) v += __shfl_xor(v, o);
    return v;
}
__device__ __forceinline__ float bf_lo(unsigned u) { return __uint_as_float(u << 16); }
__device__ __forceinline__ float bf_hi(unsigned u) { return __uint_as_float(u & 0xffff0000u); }
typedef _Float16 h16x2 __attribute__((ext_vector_type(2)));
__device__ __forceinline__ unsigned pk_f16(float a, float b) { h16x2 v; v[0] = (_Float16)a; v[1] = (_Float16)b; return __builtin_bit_cast(unsigned, v); }
__device__ __forceinline__ float f16_lo(unsigned u) { return (float)__builtin_bit_cast(h16x2, u)[0]; }
__device__ __forceinline__ float f16_hi(unsigned u) { return (float)__builtin_bit_cast(h16x2, u)[1]; }

__device__ __forceinline__ void h0_phase(const float* x, const float* ctx, const float* modl, bf16_t* HB, int gw, int NGW, int lane, int rstart = -1) {
    for (int r = rstart < 0 ? gw : rstart; r < MT; r += NGW) {
        const float* src = r < ML ? x + (size_t)r * D : ctx + (size_t)(r - ML) * D;
        const float* sh = modl + (size_t)vec_of_row(r) * NMODC; const float* sc = sh + D;
        bf16_t* o = HB + hb_off(r, 4 * lane);
#pragma unroll
        for (int j = 0; j < 8; ++j) {
            const f32x4 v = *((const f32x4*)src + lane + 64 * j), a = *((const f32x4*)sc + lane + 64 * j), b = *((const f32x4*)sh + lane + 64 * j);
            const f32x4 h = v * (a + 1.f) + b;
            u32x2 w; w.x = cvt_pk_bf16(h[0], h[1]); w.y = cvt_pk_bf16(h[2], h[3]); *(u32x2*)(o + (size_t)j * 4 * 16384) = w;
        }
    }
}
#define H0_LD1(dst, ptr, off) asm volatile("global_load_dwordx4 %0, %1, off offset:" #off : "=v"(dst) : "v"(ptr) : "memory")
#define H0_LOADSET(X, r) do { const float* xp_ = x + (size_t)(r) * D + 4 * lane; const float* xq_ = xp_ + 1024; \
        H0_LD1(X[0], xp_, 0); H0_LD1(X[1], xp_, 1024); H0_LD1(X[2], xp_, 2048); H0_LD1(X[3], xp_, 3072); H0_LD1(X[4], xq_, 0); H0_LD1(X[5], xq_, 1024); H0_LD1(X[6], xq_, 2048); H0_LD1(X[7], xq_, 3072); } while (0)
#define H0_WAIT(n) asm volatile("s_waitcnt vmcnt(" #n ")" ::: "memory")
#define H0_HALF(X, i_, AP, BP) do { \
        constexpr int i = (i_); const int r = gw + i * NGW; \
        if (i >= 2 && i + 1 < 8) H0_WAIT(24); else if (i == 1) H0_WAIT(16); else if (i == 0) H0_WAIT(8); else H0_WAIT(0); \
        asm volatile("" : "+v"(X[0]), "+v"(X[1]), "+v"(X[2]), "+v"(X[3]), "+v"(X[4]), "+v"(X[5]), "+v"(X[6]), "+v"(X[7]) :: "memory");        \
        u32x2 w[8]; \
        _Pragma("unroll") for (int j = 0; j < 8; ++j) { \
            asm volatile("" : "+v"(AP[j]), "+v"(BP[j]));           \
            const f32x4 v = __builtin_bit_cast(f32x4, X[j]); \
            const f32x4 a = (f32x4){f16_lo(AP[j].x), f16_hi(AP[j].x), f16_lo(AP[j].y), f16_hi(AP[j].y)}, b = (f32x4){f16_lo(BP[j].x), f16_hi(BP[j].x), f16_lo(BP[j].y), f16_hi(BP[j].y)}; \
            const f32x4 h = v * a + b; w[j].x = cvt_pk_bf16(h[0], h[1]); w[j].y = cvt_pk_bf16(h[2], h[3]); } \
        if (i + 2 < 8) H0_LOADSET(X, r + 2 * NGW);                 \
        bf16_t* o = HB + hb_off(r, 4 * lane); \
        _Pragma("unroll") for (int j = 0; j < 8; ++j) *(u32x2*)(o + (size_t)j * 4 * 16384) = w[j]; \
    } while (0)
__device__ __forceinline__ void h0b_phase(const float* x, const float* ctx, const float* modl, bf16_t* HB, int gw, int NGW, int lane) {
    u32x2 a0[8], b0[8], a1[8], b1[8];
#pragma unroll
    for (int j = 0; j < 8; ++j) {
        const float* sh0 = modl; const float* sh1 = modl + NMODC;
        const f32x4 s0 = *((const f32x4*)(sh0 + D) + lane + 64 * j) + 1.f, t0 = *((const f32x4*)sh0 + lane + 64 * j), s1 = *((const f32x4*)(sh1 + D) + lane + 64 * j) + 1.f, t1 = *((const f32x4*)sh1 + lane + 64 * j);
        a0[j].x = pk_f16(s0[0], s0[1]); a0[j].y = pk_f16(s0[2], s0[3]); b0[j].x = pk_f16(t0[0], t0[1]); b0[j].y = pk_f16(t0[2], t0[3]);
        a1[j].x = pk_f16(s1[0], s1[1]); a1[j].y = pk_f16(s1[2], s1[3]); b1[j].x = pk_f16(t1[0], t1[1]); b1[j].y = pk_f16(t1[2], t1[3]);
    }
#pragma unroll
    for (int j = 0; j < 8; ++j) asm volatile("" : "+v"(a0[j]), "+v"(b0[j]), "+v"(a1[j]), "+v"(b1[j]));
    asm volatile("s_waitcnt vmcnt(0)" ::: "memory");
    u32x4 xa[8], xb[8];
    H0_LOADSET(xa, gw); H0_LOADSET(xb, gw + NGW);
    H0_HALF(xa, 0, a0, b0); H0_HALF(xb, 1, a0, b0); H0_HALF(xa, 2, a0, b0); H0_HALF(xb, 3, a0, b0); H0_HALF(xa, 4, a1, b1); H0_HALF(xb, 5, a1, b1); H0_HALF(xa, 6, a1, b1); H0_HALF(xb, 7, a1, b1);
    h0_phase(x, ctx, modl, HB, gw, NGW, lane, gw + 8 * NGW);
}
#undef H0_LD1
#undef H0_LOADSET
#undef H0_WAIT
#undef H0_HALF
template <bool XF32, bool OUTF32, bool HPERM = false>
__device__ __forceinline__ void ln2_phase(const void* xsrc, const bf16_t* YB, void* xdst, bf16_t* HB, const float* lng, const float* lnb, const float* modn, int ish, int gw, int NGW, int lane) {
    const int half = NGW >> 1, b = gw >= half ? 1 : 0, gwl = gw - b * half;
    f32x4 g[4][2], bb[4][2], ha[4][2], hb[4][2];
#pragma unroll
    for (int j = 0; j < 4; ++j)
#pragma unroll
        for (int e = 0; e < 2; ++e) {
            const int c = 8 * lane + 512 * j + 4 * e;
            g[j][e] = *(const f32x4*)(lng + c); bb[j][e] = *(const f32x4*)(lnb + c);
            if (HB) { const float* sh = modn + (size_t)b * NMODC + (size_t)ish * D; const f32x4 s1 = *(const f32x4*)(sh + D + c) + 1.f, s0 = *(const f32x4*)(sh + c);
                ha[j][e] = g[j][e] * s1; hb[j][e] = bb[j][e] * s1 + s0; }
            else { ha[j][e] = g[j][e]; hb[j][e] = bb[j][e]; }
        }
    const int r0 = b * SEQ + gwl, rend = (b + 1) * SEQ;
    f32x4 xf[4][2]; u32x4 xr[4], yr[4];
#define LN2_LOAD(r) do { _Pragma("unroll") for (int j = 0; j < 4; ++j) { \
        if (XF32) { xf[j][0] = *(const f32x4*)((const float*)xsrc + (size_t)(r) * D + 8 * lane + 512 * j); xf[j][1] = *(const f32x4*)((const float*)xsrc + (size_t)(r) * D + 8 * lane + 512 * j + 4); } \
        else xr[j] = *(const u32x4*)((const bf16_t*)xsrc + (size_t)(r) * D + 8 * lane + 512 * j); \
        yr[j] = *(const u32x4*)(YB + (size_t)(r) * D + 8 * lane + 512 * j); } } while (0)
    if (!XF32 && r0 < rend) LN2_LOAD(r0);
    for (int r = r0; r < rend; r += half) {
        if (XF32) LN2_LOAD(r);
        f32x4 z[4][2]; float s = 0.f;
#pragma unroll
        for (int j = 0; j < 4; ++j) {
            f32x4 x0, x1;
            if (XF32) { x0 = xf[j][0]; x1 = xf[j][1]; }
            else { x0 = (f32x4){f16_lo(xr[j][0]), f16_hi(xr[j][0]), f16_lo(xr[j][1]), f16_hi(xr[j][1])}; x1 = (f32x4){f16_lo(xr[j][2]), f16_hi(xr[j][2]), f16_lo(xr[j][3]), f16_hi(xr[j][3])}; }
            const f32x4 y0 = (f32x4){bf_lo(yr[j][0]), bf_hi(yr[j][0]), bf_lo(yr[j][1]), bf_hi(yr[j][1])}, y1 = (f32x4){bf_lo(yr[j][2]), bf_hi(yr[j][2]), bf_lo(yr[j][3]), bf_hi(yr[j][3])};
            z[j][0] = x0 * ALPHA + y0; z[j][1] = x1 * ALPHA + y1;
            s += ((z[j][0][0] + z[j][0][1]) + (z[j][0][2] + z[j][0][3])) + ((z[j][1][0] + z[j][1][1]) + (z[j][1][2] + z[j][1][3]));
        }
        if (!XF32 && r + half < rend) LN2_LOAD(r + half);
        const float mean = wave_sum(s) * (1.f / D); float q = 0.f;
#pragma unroll
        for (int j = 0; j < 4; ++j)
#pragma unroll
            for (int e = 0; e < 2; ++e) { z[j][e] = z[j][e] - mean; q += (z[j][e][0] * z[j][e][0] + z[j][e][1] * z[j][e][1]) + (z[j][e][2] * z[j][e][2] + z[j][e][3] * z[j][e][3]); }
        const float rstd = 1.f / sqrtf(wave_sum(q) * (1.f / D) + LN_EPS);
#pragma unroll
        for (int j = 0; j < 4; ++j) {
            const f32x4 n0 = z[j][0] * rstd, n1 = z[j][1] * rstd;
            const f32x4 o0 = n0 * g[j][0] + bb[j][0], o1 = n1 * g[j][1] + bb[j][1];
            if (OUTF32) { float* op = (float*)xdst + (size_t)r * D + 8 * lane + 512 * j; *(f32x4*)op = o0; *(f32x4*)(op + 4) = o1; }
            else { u32x4 w; w.x = pk_f16(o0[0], o0[1]); w.y = pk_f16(o0[2], o0[3]); w.z = pk_f16(o1[0], o1[1]); w.w = pk_f16(o1[2], o1[3]); *(u32x4*)((bf16_t*)xdst + (size_t)r * D + 8 * lane + 512 * j) = w; }
            if (HB) { const f32x4 h0 = n0 * ha[j][0] + hb[j][0], h1 = n1 * ha[j][1] + hb[j][1];
                u32x4 w; w.x = cvt_pk_bf16(h0[0], h0[1]); w.y = cvt_pk_bf16(h0[2], h0[3]); w.z = cvt_pk_bf16(h1[0], h1[1]); w.w = cvt_pk_bf16(h1[2], h1[3]); const int rh = HPERM ? ((r & ~255) | slot_of_tok(r & 255)) : r; *(u32x4*)(HB + hb_off(rh, 8 * lane + 512 * j)) = w; }
        }
    }
#undef LN2_LOAD
}
#define LN3_LD1(dst, ptr, off) asm volatile("global_load_dwordx4 %0, %1, off offset:" #off : "=v"(dst) : "v"(ptr) : "memory")
#define LN3_LOADSET(X, Y, r) do { const bf16_t* yp_ = YB + (size_t)(r) * D + 8 * lane; \
        if constexpr (XF32) { const float* xp_ = (const float*)xsrc + (size_t)(r) * D + 8 * lane; const float* xq_ = xp_ + 1024;        \
            LN3_LD1(X[0], xp_, 0); LN3_LD1(X[1], xp_, 16); LN3_LD1(Y[0], yp_, 0); LN3_LD1(X[2], xp_, 2048); LN3_LD1(X[3], xp_, 2064); LN3_LD1(Y[1], yp_, 1024); \
            LN3_LD1(X[4], xq_, 0); LN3_LD1(X[5], xq_, 16); LN3_LD1(Y[2], yp_, 2048); LN3_LD1(X[6], xq_, 2048); LN3_LD1(X[7], xq_, 2064); LN3_LD1(Y[3], yp_, 3072); } \
        else { const bf16_t* xp_ = (const bf16_t*)xsrc + (size_t)(r) * D + 8 * lane; \
            LN3_LD1(X[0], xp_, 0); LN3_LD1(Y[0], yp_, 0); LN3_LD1(X[1], xp_, 1024); LN3_LD1(Y[1], yp_, 1024); LN3_LD1(X[2], xp_, 2048); LN3_LD1(Y[2], yp_, 2048); LN3_LD1(X[3], xp_, 3072); LN3_LD1(Y[3], yp_, 3072); } } while (0)
#define LN3_WAIT(n) asm volatile("s_waitcnt vmcnt(" #n ")" ::: "memory")
#define LN3_PIN(X, Y) do { if constexpr (XF32) asm volatile("" : "+v"(X[0]), "+v"(X[1]), "+v"(X[2]), "+v"(X[3]), "+v"(X[4]), "+v"(X[5]), "+v"(X[6]), "+v"(X[7]), "+v"(Y[0]), "+v"(Y[1]), "+v"(Y[2]), "+v"(Y[3]) :: "memory"); \
        else asm volatile("" : "+v"(X[0]), "+v"(X[1]), "+v"(X[2]), "+v"(X[3]), "+v"(Y[0]), "+v"(Y[1]), "+v"(Y[2]), "+v"(Y[3]) :: "memory"); } while (0)
#define LN3_HALF(X, Y, i_) do { \
        const int i = (i_), r = r0 + i * half; \
        if (i >= 2 && i + 1 < n) { if constexpr (XF32) LN3_WAIT(28); else LN3_WAIT(24); } else if (i == 1) { if constexpr (XF32) LN3_WAIT(20); else LN3_WAIT(16); } \
        else if (i == 0) { if constexpr (XF32) LN3_WAIT(12); else LN3_WAIT(8); } else LN3_WAIT(0);        \
        LN3_PIN(X, Y);                                             \
        f32x4 z[4][2]; float s = 0.f; \
        _Pragma("unroll") for (int j = 0; j < 4; ++j) { \
            f32x4 x0, x1; \
            if constexpr (XF32) { x0 = __builtin_bit_cast(f32x4, X[2 * j]); x1 = __builtin_bit_cast(f32x4, X[2 * j + 1]); } \
            else { x0 = (f32x4){f16_lo(X[j][0]), f16_hi(X[j][0]), f16_lo(X[j][1]), f16_hi(X[j][1])}; x1 = (f32x4){f16_lo(X[j][2]), f16_hi(X[j][2]), f16_lo(X[j][3]), f16_hi(X[j][3])}; } \
            const f32x4 y0 = (f32x4){bf_lo(Y[j][0]), bf_hi(Y[j][0]), bf_lo(Y[j][1]), bf_hi(Y[j][1])}, y1 = (f32x4){bf_lo(Y[j][2]), bf_hi(Y[j][2]), bf_lo(Y[j][3]), bf_hi(Y[j][3])}; \
            z[j][0] = x0 * ALPHA + y0; z[j][1] = x1 * ALPHA + y1; \
            s += ((z[j][0][0] + z[j][0][1]) + (z[j][0][2] + z[j][0][3])) + ((z[j][1][0] + z[j][1][1]) + (z[j][1][2] + z[j][1][3])); } \
        if (i + 2 < n) LN3_LOADSET(X, Y, r + 2 * half);            \
        const float mean = wave_sum(s) * (1.f / D); float q = 0.f; \
        _Pragma("unroll") for (int j = 0; j < 4; ++j) _Pragma("unroll") for (int e = 0; e < 2; ++e) { z[j][e] = z[j][e] - mean; q += (z[j][e][0] * z[j][e][0] + z[j][e][1] * z[j][e][1]) + (z[j][e][2] * z[j][e][2] + z[j][e][3] * z[j][e][3]); } \
        const float rstd = 1.f / sqrtf(wave_sum(q) * (1.f / D) + LN_EPS); \
        _Pragma("unroll") for (int j = 0; j < 4; ++j) { \
            const f32x4 n0 = z[j][0] * rstd, n1 = z[j][1] * rstd; \
            f32x4 g0, g1, b0, b1; \
            if constexpr (OUTF32) { g0 = gf[j][0]; g1 = gf[j][1]; b0 = bf[j][0]; b1 = bf[j][1]; } \
            else { asm volatile("" : "+v"(gp[j]), "+v"(bp[j]), "+v"(hap[j]), "+v"(hbp[j]));        \
                g0 = (f32x4){f16_lo(gp[j][0]), f16_hi(gp[j][0]), f16_lo(gp[j][1]), f16_hi(gp[j][1])}; g1 = (f32x4){f16_lo(gp[j][2]), f16_hi(gp[j][2]), f16_lo(gp[j][3]), f16_hi(gp[j][3])}; \
                b0 = (f32x4){f16_lo(bp[j][0]), f16_hi(bp[j][0]), f16_lo(bp[j][1]), f16_hi(bp[j][1])}; b1 = (f32x4){f16_lo(bp[j][2]), f16_hi(bp[j][2]), f16_lo(bp[j][3]), f16_hi(bp[j][3])}; } \
            const f32x4 o0 = n0 * g0 + b0, o1 = n1 * g1 + b1; \
            if constexpr (OUTF32) { float* op = (float*)xdst + (size_t)r * D + 8 * lane + 512 * j; *(f32x4*)op = o0; *(f32x4*)(op + 4) = o1; }        \
            else { \
            { u32x4 w; w.x = pk_f16(o0[0], o0[1]); w.y = pk_f16(o0[2], o0[3]); w.z = pk_f16(o1[0], o1[1]); w.w = pk_f16(o1[2], o1[3]); *(u32x4*)((bf16_t*)xdst + (size_t)r * D + 8 * lane + 512 * j) = w; } \
            { const f32x4 a0 = (f32x4){f16_lo(hap[j][0]), f16_hi(hap[j][0]), f16_lo(hap[j][1]), f16_hi(hap[j][1])}, a1 = (f32x4){f16_lo(hap[j][2]), f16_hi(hap[j][2]), f16_lo(hap[j][3]), f16_hi(hap[j][3])}; \
              const f32x4 c0 = (f32x4){f16_lo(hbp[j][0]), f16_hi(hbp[j][0]), f16_lo(hbp[j][1]), f16_hi(hbp[j][1])}, c1 = (f32x4){f16_lo(hbp[j][2]), f16_hi(hbp[j][2]), f16_lo(hbp[j][3]), f16_hi(hbp[j][3])}; \
              const f32x4 h0 = n0 * a0 + c0, h1 = n1 * a1 + c1; \
              u32x4 w; w.x = cvt_pk_bf16(h0[0], h0[1]); w.y = cvt_pk_bf16(h0[2], h0[3]); w.z = cvt_pk_bf16(h1[0], h1[1]); w.w = cvt_pk_bf16(h1[2], h1[3]); *(u32x4*)(HB + hb_off(r, 8 * lane + 512 * j)) = w; } } } \
    } while (0)
template <bool XF32, bool OUTF32>
__device__ __forceinline__ void ln3_phase(const void* xsrc, const bf16_t* YB, void* xdst, bf16_t* HB, const float* lng, const float* lnb, const float* modn, int ish, int gw, int NGW, int lane) {
    const int half = NGW >> 1, b = gw >= half ? 1 : 0, gwl = gw - b * half;
    u32x4 gp[4], bp[4], hap[4], hbp[4]; f32x4 gf[4][2], bf[4][2];
#pragma unroll
    for (int j = 0; j < 4; ++j) {
        f32x4 gv[2], bv[2], hav[2], hbv[2];
#pragma unroll
        for (int e = 0; e < 2; ++e) {
            const int c = 8 * lane + 512 * j + 4 * e;
            gv[e] = *(const f32x4*)(lng + c); bv[e] = *(const f32x4*)(lnb + c);
            if constexpr (OUTF32) { gf[j][e] = gv[e]; bf[j][e] = bv[e]; hav[e] = gv[e]; hbv[e] = bv[e]; continue; }
            const float* sh = modn + (size_t)b * NMODC + (size_t)ish * D; const f32x4 s1 = *(const f32x4*)(sh + D + c) + 1.f, s0 = *(const f32x4*)(sh + c);
            hav[e] = gv[e] * s1; hbv[e] = bv[e] * s1 + s0;
        }
        gp[j].x = pk_f16(gv[0][0], gv[0][1]); gp[j].y = pk_f16(gv[0][2], gv[0][3]); gp[j].z = pk_f16(gv[1][0], gv[1][1]); gp[j].w = pk_f16(gv[1][2], gv[1][3]);
        bp[j].x = pk_f16(bv[0][0], bv[0][1]); bp[j].y = pk_f16(bv[0][2], bv[0][3]); bp[j].z = pk_f16(bv[1][0], bv[1][1]); bp[j].w = pk_f16(bv[1][2], bv[1][3]);
        hap[j].x = pk_f16(hav[0][0], hav[0][1]); hap[j].y = pk_f16(hav[0][2], hav[0][3]); hap[j].z = pk_f16(hav[1][0], hav[1][1]); hap[j].w = pk_f16(hav[1][2], hav[1][3]);
        hbp[j].x = pk_f16(hbv[0][0], hbv[0][1]); hbp[j].y = pk_f16(hbv[0][2], hbv[0][3]); hbp[j].z = pk_f16(hbv[1][0], hbv[1][1]); hbp[j].w = pk_f16(hbv[1][2], hbv[1][3]);
    }
    const int r0 = b * SEQ + gwl;
#pragma unroll
    for (int j = 0; j < 4; ++j) { if constexpr (OUTF32) asm volatile("" : "+v"(gf[j][0]), "+v"(gf[j][1]), "+v"(bf[j][0]), "+v"(bf[j][1])); else asm volatile("" : "+v"(gp[j]), "+v"(bp[j]), "+v"(hap[j]), "+v"(hbp[j])); }
    asm volatile("s_waitcnt vmcnt(0)" ::: "memory");
    u32x4 xa[XF32 ? 8 : 4], ya[4], xb[XF32 ? 8 : 4], yb[4];
    LN3_LOADSET(xa, ya, r0);
    LN3_LOADSET(xb, yb, r0 + half);
    constexpr int n = 8;
    LN3_HALF(xa, ya, 0); LN3_HALF(xb, yb, 1); LN3_HALF(xa, ya, 2); LN3_HALF(xb, yb, 3); LN3_HALF(xa, ya, 4); LN3_HALF(xb, yb, 5); LN3_HALF(xa, ya, 6); LN3_HALF(xb, yb, 7);
}
#undef LN3_LOADSET
#undef LN3_LD1
#undef LN3_WAIT
#undef LN3_PIN
#undef LN3_HALF
__device__ __forceinline__ void ln_ctx_phase(const float* srcC, const bf16_t* slab, int nparts, float* Xc, bf16_t* HBc, const float* lng, const float* lnb, const float* modn, int ish,
                                             LAS float* red, int bid, int G, int tid, int lane, int wave) {
    const f32x4 gv = *(const f32x4*)(lng + 4 * tid), bv = *(const f32x4*)(lnb + 4 * tid);
    const float* sh = modn + (size_t)2 * NMODC + (size_t)ish * D; const float* sc = sh + D;
    const f32x4 s1 = *(const f32x4*)(sc + 4 * tid) + 1.f, s0 = *(const f32x4*)(sh + 4 * tid);
    for (int rr = bid; rr < MC; rr += 2 * G) {
        const int r2 = rr + G; const bool two = r2 < MC; const int rb = two ? r2 : rr;
        f32x4 za = *(const f32x4*)(srcC + (size_t)rr * D + 4 * tid) * ALPHA, zb = *(const f32x4*)(srcC + (size_t)rb * D + 4 * tid) * ALPHA;
        for (int s = 0; s < nparts; ++s) {
            const u32x2 pa = *(const u32x2*)(slab + ((size_t)s * MC + rr) * D + 4 * tid), pb = *(const u32x2*)(slab + ((size_t)s * MC + rb) * D + 4 * tid);
            za += (f32x4){bf_lo(pa.x), bf_hi(pa.x), bf_lo(pa.y), bf_hi(pa.y)}; zb += (f32x4){bf_lo(pb.x), bf_hi(pb.x), bf_lo(pb.y), bf_hi(pb.y)};
        }
        const float sa = wave_sum((za[0] + za[1]) + (za[2] + za[3])), sb = wave_sum((zb[0] + zb[1]) + (zb[2] + zb[3]));
        __syncthreads();
        if (lane == 0) { red[wave] = sa; red[8 + wave] = sb; }
        __syncthreads();
        float ta = 0.f, tb = 0.f;
#pragma unroll
        for (int w = 0; w < 8; ++w) { ta += red[w]; tb += red[8 + w]; }
        za = za - ta * (1.f / D); zb = zb - tb * (1.f / D);
        const float qa = wave_sum((za[0] * za[0] + za[1] * za[1]) + (za[2] * za[2] + za[3] * za[3])), qb = wave_sum((zb[0] * zb[0] + zb[1] * zb[1]) + (zb[2] * zb[2] + zb[3] * zb[3]));
        __syncthreads();
        if (lane == 0) { red[wave] = qa; red[8 + wave] = qb; }
        __syncthreads();
        float ua = 0.f, ub = 0.f;
#pragma unroll
        for (int w = 0; w < 8; ++w) { ua += red[w]; ub += red[8 + w]; }
        const float ra = 1.f / sqrtf(ua * (1.f / D) + LN_EPS), rbs = 1.f / sqrtf(ub * (1.f / D) + LN_EPS);
        const f32x4 xa = za * ra * gv + bv, xb = zb * rbs * gv + bv;
        *(f32x4*)(Xc + (size_t)rr * D + 4 * tid) = xa; *(f32x4*)(Xc + (size_t)rb * D + 4 * tid) = xb;
        const f32x4 ha = xa * s1 + s0, hb2 = xb * s1 + s0;
        u32x2 wa, wb; wa.x = cvt_pk_bf16(ha[0], ha[1]); wa.y = cvt_pk_bf16(ha[2], ha[3]); wb.x = cvt_pk_bf16(hb2[0], hb2[1]); wb.y = cvt_pk_bf16(hb2[2], hb2[3]);
        *(u32x2*)(HBc + hb_off(ML + rr, 4 * tid)) = wa; *(u32x2*)(HBc + hb_off(ML + rb, 4 * tid)) = wb;
    }
    __syncthreads();
}
__device__ __forceinline__ void conv_phase(const bf16_t* GB, const bf16_t* VB, const float* wconv, bf16_t* A2, int gw, int NGW, int lane, int rstart = -1) {
    f32x4 w[3][4];
#pragma unroll
    for (int k = 0; k < 3; ++k)
#pragma unroll
        for (int q = 0; q < 4; ++q) w[k][q] = *((const f32x4*)(wconv + k * 1024 + 16 * lane) + q);
    for (int r = rstart < 0 ? gw : rstart; r < MT; r += NGW) {
        int pos, L; if (r < ML) { pos = r & (SEQ - 1); L = SEQ; } else { pos = (r - ML) & (CTXL - 1); L = CTXL; }
        const u32x4 z4 = (u32x4){0u, 0u, 0u, 0u};
        const u32x4* vc = (const u32x4*)(VB + (size_t)r * 1024 + 16 * lane);
        const u32x4* gp = (const u32x4*)(GB + (size_t)r * 1024 + 16 * lane);
        u32x4 o[2];
#pragma unroll
        for (int h = 0; h < 2; ++h) {
            const u32x4 c = vc[h], p = pos > 0 ? vc[h - 128] : z4, n = pos < L - 1 ? vc[h + 128] : z4, g = gp[h];
            u32x4 ov;
#pragma unroll
            for (int e = 0; e < 4; ++e) {
                const f32x4 w0 = w[0][2 * h + (e >> 1)], w1 = w[1][2 * h + (e >> 1)], w2 = w[2][2 * h + (e >> 1)];
                const int i0 = (e & 1) * 2;
                const float lo = bf_lo(g[e]) * (w0[i0] * bf_lo(p[e]) + w1[i0] * bf_lo(c[e]) + w2[i0] * bf_lo(n[e]));
                const float hi = bf_hi(g[e]) * (w0[i0 + 1] * bf_hi(p[e]) + w1[i0 + 1] * bf_hi(c[e]) + w2[i0 + 1] * bf_hi(n[e]));
                ov[e] = cvt_pk_bf16(lo, hi);
            }
            o[h] = ov;
        }
        u32x4* op = (u32x4*)(A2 + hb_off(r, 16 * lane)); op[0] = o[0]; op[1] = o[1];
    }
}

#define CV_LD1(dst, ptr, off) asm volatile("global_load_dwordx4 %0, %1, off offset:" #off : "=v"(dst) : "v"(ptr) : "memory")
#define CV_LOADSET(X, r_) do { const int rr_ = (r_), ps_ = rr_ & (SEQ - 1); const int rp_ = ps_ > 0 ? rr_ - 1 : rr_, rn_ = ps_ < SEQ - 1 ? rr_ + 1 : rr_; \
        const bf16_t* c_ = VB + (size_t)rr_ * 1024 + 16 * lane; const bf16_t* p_ = VB + (size_t)rp_ * 1024 + 16 * lane; const bf16_t* n_ = VB + (size_t)rn_ * 1024 + 16 * lane; const bf16_t* g_ = GB + (size_t)rr_ * 1024 + 16 * lane; \
        CV_LD1(X[0], c_, 0); CV_LD1(X[1], c_, 16); CV_LD1(X[2], p_, 0); CV_LD1(X[3], p_, 16); CV_LD1(X[4], n_, 0); CV_LD1(X[5], n_, 16); CV_LD1(X[6], g_, 0); CV_LD1(X[7], g_, 16); } while (0)
#define CV_WAIT(n) asm volatile("s_waitcnt vmcnt(" #n ")" ::: "memory")
#define CV_HALF(X, i_) do { \
        constexpr int i = (i_); const int r = gw + i * NGW, pos = r & (SEQ - 1); \
        if (i >= 2 && i + 1 < 8) CV_WAIT(12); else if (i == 1) CV_WAIT(10); else if (i == 0) CV_WAIT(8); else CV_WAIT(0);        \
        asm volatile("" : "+v"(X[0]), "+v"(X[1]), "+v"(X[2]), "+v"(X[3]), "+v"(X[4]), "+v"(X[5]), "+v"(X[6]), "+v"(X[7]) :: "memory"); \
        u32x4 o[2]; \
        _Pragma("unroll") for (int h = 0; h < 2; ++h) { \
            const u32x4 z4 = (u32x4){0u, 0u, 0u, 0u}; const u32x4 c = X[h], p = pos > 0 ? X[2 + h] : z4, nx = pos < SEQ - 1 ? X[4 + h] : z4, g = X[6 + h]; \
            u32x4 ov; \
            _Pragma("unroll") for (int e = 0; e < 4; ++e) { \
                const f32x4 w0 = w[0][2 * h + (e >> 1)], w1 = w[1][2 * h + (e >> 1)], w2 = w[2][2 * h + (e >> 1)]; \
                const int i0 = (e & 1) * 2; \
                const float lo = bf_lo(g[e]) * (w0[i0] * bf_lo(p[e]) + w1[i0] * bf_lo(c[e]) + w2[i0] * bf_lo(nx[e])); \
                const float hi = bf_hi(g[e]) * (w0[i0 + 1] * bf_hi(p[e]) + w1[i0 + 1] * bf_hi(c[e]) + w2[i0 + 1] * bf_hi(nx[e])); \
                ov[e] = cvt_pk_bf16(lo, hi); } \
            o[h] = ov; } \
        if (i + 2 < 8) CV_LOADSET(X, r + 2 * NGW); \
        { u32x4* op = (u32x4*)(A2 + hb_off(r, 16 * lane)); op[0] = o[0]; op[1] = o[1]; } \
    } while (0)
__device__ __forceinline__ void conv3_phase(const bf16_t* GB, const bf16_t* VB, const float* wconv, bf16_t* A2, int gw, int NGW, int lane) {
    f32x4 w[3][4];
#pragma unroll
    for (int k = 0; k < 3; ++k)
#pragma unroll
        for (int q = 0; q < 4; ++q) w[k][q] = *((const f32x4*)(wconv + k * 1024 + 16 * lane) + q);
#pragma unroll
    for (int k = 0; k < 3; ++k)
#pragma unroll
        for (int q = 0; q < 4; ++q) asm volatile("" : "+v"(w[k][q]));
    asm volatile("s_waitcnt vmcnt(0)" ::: "memory");
    u32x4 xa[8], xb[8];
    CV_LOADSET(xa, gw); CV_LOADSET(xb, gw + NGW);
    CV_HALF(xa, 0); CV_HALF(xb, 1); CV_HALF(xa, 2); CV_HALF(xb, 3); CV_HALF(xa, 4); CV_HALF(xb, 5); CV_HALF(xa, 6); CV_HALF(xb, 7);
    conv_phase(GB, VB, wconv, A2, gw, NGW, lane, gw + 8 * NGW);
}
#undef CV_LD1
#undef CV_LOADSET
#undef CV_WAIT
#undef CV_HALF

struct Params {
    const float *x, *c, *ctx, *c_ctx, *w_mod, *b_mod, *ln_g, *ln_b, *wg, *wu, *wd, *ab_in, *ab_conv, *ab_out, *at_in, *at_sink, *at_out;
    float* out; unsigned char* ws; int ph_lo, ph_hi;
};
__device__ __forceinline__ int swz128(int j, int half) { return 256 * (j >> 7) + 128 * half + (j & 127); }

constexpr int CP_NFFN = 12 * 5632, CP_NITEMS = CP_NFFN + 4 * 1024 + 2048 + 2560 + 2048;
constexpr int CP_MAT = 5632, CP_OTH0 = CP_NFFN, CP_OTH1 = CP_NFFN + 6144;
struct TrDesc { const float* W; bf16_t* WT; int K, ldn, c0, drow0, kb; bool blk; bool perm; };
__device__ __forceinline__ TrDesc copy_desc(const Params& P, int it) {
    unsigned char* ws = P.ws; TrDesc d; d.perm = true;
    if (it < CP_NFFN) {
        const int mi = it / 5632, r = it % 5632, idx = mi / 3, ty = mi % 3;
        if (ty < 2) { const int nb = r % 176; d.kb = r / 176; d.W = (ty == 0 ? P.wg : P.wu) + (size_t)idx * D * FF; d.K = D; d.ldn = FF; d.c0 = 32 * nb;
            d.WT = (bf16_t*)(ws + WS_W1I + (size_t)idx * W1I_BYTES); d.drow0 = swz128(32 * nb, ty); d.blk = true; }
        else { const int nb = r % 64; d.kb = r / 64; d.W = P.wd + (size_t)idx * FF * D; d.K = FF; d.ldn = D; d.c0 = 32 * nb; d.WT = (bf16_t*)(ws + WS_W2T + (size_t)idx * W2T_BYTES); d.drow0 = 32 * nb; d.blk = true; }
        return d;
    }
    int r = it - CP_NFFN; d.K = D; d.blk = true;
    if (r < 4096) { const int seg = r >> 10, q = r & 1023, nb = q & 31; d.kb = q >> 5; d.W = P.ab_in; d.ldn = 4096; d.c0 = seg * 1024 + 32 * nb; d.WT = (bf16_t*)(ws + WS_WMI);
        d.drow0 = seg == 0 ? 32 * nb : (seg == 3 ? 3072 + 32 * nb : 1024 + swz128(32 * nb, seg - 1)); return d; }
    r -= 4096;
    if (r < 2048) { const int nb = r & 63; d.kb = r >> 6; d.W = P.ab_out; d.ldn = D; d.c0 = 32 * nb; d.WT = (bf16_t*)(ws + WS_WMO); d.drow0 = 32 * nb; return d; }
    r -= 2048;
    if (r < 2560) { const int nb = r % 80; d.kb = r / 80; d.W = P.at_in; d.ldn = 2560; d.perm = false; d.c0 = 32 * nb; d.WT = (bf16_t*)(ws + WS_WQKV); d.drow0 = 32 * nb; return d; }
    r -= 2560;
    { const int nb = r & 63; d.kb = r >> 6; d.W = P.at_out; d.ldn = D; d.c0 = 32 * nb; d.WT = (bf16_t*)(ws + WS_WO); d.drow0 = 32 * nb; return d; }
}
__device__ __forceinline__ void tr_load(const TrDesc& d, f32x4 (&v)[8], int lane) {
    const float* src = d.W + (size_t)(64 * d.kb + (lane >> 3)) * d.ldn + d.c0 + 4 * (lane & 7);
#pragma unroll
    for (int i = 0; i < 8; ++i) v[i] = __builtin_nontemporal_load((const f32x4*)(src + (size_t)(8 * i) * d.ldn));
}
__device__ __forceinline__ void tr_store(const TrDesc& d, const f32x4 (&v)[8], LAS float* scr, int lane) {
#pragma unroll
    for (int i = 0; i < 8; ++i) { LAS float* p = scr + (8 * i + (lane >> 3)) * 33 + 4 * (lane & 7); p[0] = v[i][0]; p[1] = v[i][1]; p[2] = v[i][2]; p[3] = v[i][3]; }
    LDS_WAIT(); asm volatile("" ::: "memory");
    const int c = lane & 7;
#pragma unroll
    for (int j = 0; j < 4; ++j) { const int n = (lane >> 3) + 8 * j; const LAS float* s = scr + (8 * c) * 33 + n;
        u32x4 o; o.x = cvt_pk_bf16(s[0 * 33], s[1 * 33]); o.y = cvt_pk_bf16(s[2 * 33], s[3 * 33]); o.z = cvt_pk_bf16(s[4 * 33], s[5 * 33]); o.w = cvt_pk_bf16(s[6 * 33], s[7 * 33]);
        const int dr = d.drow0 + n;
        if (d.blk) { int R = dr & 127; if (d.perm) { const int v = R & 31; R = (R & ~31) + 16 * ((v >> 2) & 1) + 4 * (v >> 3) + (v & 3); }
            *(u32x4*)(d.WT + (size_t)(dr >> 8) * 256 * d.K + (size_t)d.kb * 16384 + ((dr >> 7) & 1) * 8192 + (lds_img_byte(R, 8 * c) >> 1)) = o; }
        else *(u32x4*)(d.WT + (size_t)dr * d.K + 64 * d.kb + 8 * c) = o; }
    LDS_WAIT(); asm volatile("" ::: "memory");
}
__device__ __forceinline__ void copy_range(const Params& P, LAS float* scr, int lo, int hi, int slot, int nslots, int lane) {
    for (int it = lo + slot; it < hi; it += nslots) { const TrDesc d = copy_desc(P, it); f32x4 v[8]; tr_load(d, v, lane); tr_store(d, v, scr, lane); }
}
template <int PARTS = 15>
__device__ __forceinline__ void p0_prologue(const Params& P, LAS unsigned char* lds, int tid, int lane, int wave, int bid, int G) {
    unsigned char* ws = P.ws;
    if (PARTS & 1) {
        LAS float* sl = (LAS float*)lds;
        LAS float* red = (LAS float*)(lds + 24576);
        bool have = false;
        for (int it = bid; it < 256; it += G) {
            if (!have) {
                for (int i = tid; i < 3 * D; i += 512) { const int v = i >> 11, k = i & (D - 1); const float xv = v < 2 ? P.c[v * D + k] : P.c_ctx[k]; sl[i] = xv / (1.f + expf(-xv)); }
                have = true;
            }
            __syncthreads();
            const int l = it >> 7, j0 = (it & 127) * 144, q = tid % 36, kl = tid / 36;
            if (tid < 504) {
                const float* wp = P.w_mod + (size_t)l * D * NMODC + j0 + 4 * q;
                f32x4 a0 = {0.f, 0.f, 0.f, 0.f}, a1 = a0, a2 = a0;
#pragma unroll 8
                for (int k = kl; k < D; k += 14) { const f32x4 w = __builtin_nontemporal_load((const f32x4*)(wp + (size_t)k * NMODC)); a0 += w * sl[k]; a1 += w * sl[D + k]; a2 += w * sl[2 * D + k]; }
                *(LAS f32x4*)(red + (kl * 3 + 0) * 144 + 4 * q) = a0; *(LAS f32x4*)(red + (kl * 3 + 1) * 144 + 4 * q) = a1; *(LAS f32x4*)(red + (kl * 3 + 2) * 144 + 4 * q) = a2;
            }
            __syncthreads();
            if (tid < 432) { const int v = tid / 144, col = tid % 144; float s = 0.f;
#pragma unroll
                for (int k2 = 0; k2 < 14; ++k2) s += red[(k2 * 3 + v) * 144 + col];
                ((float*)(ws + WS_MOD))[((size_t)l * 3 + v) * NMODC + j0 + col] = s + P.b_mod[(size_t)l * NMODC + j0 + col]; }
        }
        __syncthreads();
    }
    if (PARTS & 4) { LAS float* scr = (LAS float*)(lds + wave * 16384); copy_range(P, scr, 0, 2 * CP_MAT, bid * 8 + wave, G * 8, lane); copy_range(P, scr, 10 * CP_MAT, 11 * CP_MAT, bid * 8 + wave, G * 8, lane); }
    if (PARTS & 8) {
        const long gt = (long)bid * 512 + tid, NT = (long)G * 512;
        bf16_t* A1 = (bf16_t*)(ws + WS_A1);
        for (long it = gt; it < 256 * 256; it += NT) {
            const int row = (int)it >> 8, cc = (int)it & 255, part = row >> 7, k2 = row & 127, s = cc >> 7, n2 = cc & 127;
            float sn, cs; sincospif((float)((k2 * n2) & 127) * (1.f / 64.f), &sn, &cs);
            const float v = part == 0 ? (s == 0 ? cs : -sn) : (s == 0 ? -sn : -cs);
            A1[it] = (bf16_t)(cvt_pk_bf16(v, 0.f) & 0xffffu);
        }
        bf16_t* CHm = (bf16_t*)(ws + WS_CH);
        for (long it = gt; it < 512 * 32; it += NT) {
            const int row = (int)it >> 5, c0 = ((int)it & 31) * 8, gl = row >> 8, m = (row & 255) >> 1, s = row & 1, glc = c0 >> 7, cb = c0 & 127;
            if (gl != glc) { *(u32x4*)(CHm + (size_t)row * 1024 + c0) = (u32x4){0u, 0u, 0u, 0u}; continue; }
            float v[8];
#pragma unroll
            for (int e = 0; e < 8; ++e) { float sn, cs; sincospif((float)((m * (cb + e)) & 127) * (1.f / 64.f), &sn, &cs); v[e] = s == 0 ? cs : sn; }
            u32x4 o; o.x = cvt_pk_bf16(v[0], v[1]); o.y = cvt_pk_bf16(v[2], v[3]); o.z = cvt_pk_bf16(v[4], v[5]); o.w = cvt_pk_bf16(v[6], v[7]);
            *(u32x4*)(CHm + (size_t)row * 1024 + c0) = o;
        }
        bf16_t* A2M = (bf16_t*)(ws + WS_A2M);
        for (long it = gt; it < 32 * 256 * 64; it += NT) {
            const int kg = (int)(it >> 14), row = ((int)it >> 6) & 255, c0 = ((int)it & 63) * 8, k2l = row >> 6, k1 = row & 63, k2c = c0 >> 7, part = (c0 >> 6) & 1, n10 = c0 & 63;
            const int k = 4 * kg + k2l + 128 * k1;
            if (k2l != k2c) { *(u32x4*)(A2M + it * 8) = (u32x4){0u, 0u, 0u, 0u}; continue; }
            float v[8];
#pragma unroll
            for (int e = 0; e < 8; ++e) { float sn, cs; sincospif((float)((k * (n10 + e)) & 8191) * (1.f / 4096.f), &sn, &cs); v[e] = part == 0 ? cs : sn; }
            u32x4 o; o.x = cvt_pk_bf16(v[0], v[1]); o.y = cvt_pk_bf16(v[2], v[3]); o.z = cvt_pk_bf16(v[4], v[5]); o.w = cvt_pk_bf16(v[6], v[7]);
            *(u32x4*)(A2M + it * 8) = o;
        }
        bf16_t* AC = (bf16_t*)(ws + WS_ACTX);
        for (long it = gt; it < 256 * 64; it += NT) {
            const int k = (int)(it >> 6), n0 = ((int)it & 63) * 8; const bool sn = n0 >= 256; const int nb = n0 & 255;
            float v[8];
#pragma unroll
            for (int e = 0; e < 8; ++e) { const int idx = (k * (nb + e)) & 255; float s, c; sincospif((float)idx * (1.f / 128.f), &s, &c); v[e] = sn ? -s : c; }
            u32x4 o; o.x = cvt_pk_bf16(v[0], v[1]); o.y = cvt_pk_bf16(v[2], v[3]); o.z = cvt_pk_bf16(v[4], v[5]); o.w = cvt_pk_bf16(v[6], v[7]);
            *(u32x4*)(AC + (size_t)k * 512 + n0) = o;
        }
        float* rp = (float*)(ws + WS_ROPE);
        for (long it = gt; it < 128 * 16; it += NT) { const int p = (int)it >> 4, f = (int)it & 15; const float ang = (float)p * powf(10000.f, -(float)f / 16.f); rp[it] = cosf(ang); rp[2048 + it] = sinf(ang); }
    }
}

__device__ __forceinline__ int crow(int r, int hi) { return (r & 3) + 8 * (r >> 2) + 4 * hi; }
template <int ATT_MODE = 0>
__device__ __forceinline__ void attn_phase(LAS unsigned char* lds, const bf16_t* Q, const bf16_t* KB, const bf16_t* VT, const float* sink, bf16_t* O, int bid, int G, int tid, bool nostore = false) {
    const int lane = tid & 63, wid = __builtin_amdgcn_readfirstlane(tid >> 6), r32 = lane & 31, hi = lane >> 5;
    constexpr int SLOTB = 32768, VOFF = 16384;
    const int kl_off = (lane >> 3) * 256 + (((lane & 7) ^ ((lane >> 3) & 7)) * 8);
    const int vd0 = 4 * wid + (lane >> 4);
    const int vl_off = ((lane & 15) ^ (vd0 & 15)) * 8;
#define ATT_STAGE(unit_, ch_, slot_) do { \
        const int g_ = (unit_) & 3, blk_ = ((unit_) >> 2) & 63, b_ = (unit_) >> 8; \
        const long tok0_ = (ch_) < 2 ? (long)ML + b_ * CTXL + 128 * (ch_) : (long)b_ * SEQ + (blk_ + (ch_) - 3) * 128; \
        _Pragma("unroll") for (int i_ = 0; i_ < 2; ++i_) { \
            __builtin_amdgcn_global_load_lds((const unsigned*)(KB + (tok0_ + 8 * (wid + 8 * i_)) * 256 + g_ * 64 + kl_off), (LAS unsigned*)(lds + (slot_) * SLOTB + (wid + 8 * i_) * 1024), 16, 0, 0); \
            __builtin_amdgcn_global_load_lds((const unsigned*)(VT + (size_t)(g_ * 64 + vd0 + 32 * i_) * MT + tok0_ + vl_off), (LAS unsigned*)(lds + (slot_) * SLOTB + VOFF + (wid + 8 * i_) * 1024), 16, 0, 0); } } while (0)
    constexpr int QOFF = 2 * SLOTB;
    const int ql_off = (lane >> 3) * D + (((lane & 7) ^ ((lane >> 3) & 7)) * 8);
#define ATT_STAGE_Q(unit_, pass_) do { \
        const int g_ = (unit_) & 3, blk_ = ((unit_) >> 2) & 63, b_ = (unit_) >> 8; \
        const bf16_t* qb_ = Q + ((size_t)b_ * SEQ + blk_ * 128 + (pass_) * 64) * D + (g_ * 8 + wid) * 64 + ql_off; \
        _Pragma("unroll") for (int i_ = 0; i_ < 8; ++i_) \
            __builtin_amdgcn_global_load_lds((const unsigned*)(qb_ + (size_t)(8 * i_) * D), (LAS unsigned*)(lds + QOFF + wid * 8192 + i_ * 1024), 16, 0, 0); } while (0)
    int unit = bid, pass = 0, ch = 0, slot = 0;
    if (unit >= 512) { __syncthreads(); return; }
    ATT_STAGE(unit, 0, 0);
    ATT_STAGE_Q(unit, 0);
    VM_WAIT();
    __syncthreads();
    const short one_bf = (short)0x3F80; const bf16x8 ones = {one_bf, one_bf, one_bf, one_bf, one_bf, one_bf, one_bf, one_bf};
    f32x16 o[2][2], nm[2], la[2]; float mx[2]; bf16x8 qf[2][4];
    const float sk0 = sink[wid] * LOG2E, sk1 = sink[8 + wid] * LOG2E, sk2 = sink[16 + wid] * LOG2E, sk3 = sink[24 + wid] * LOG2E;
    for (;;) {
        const int g = unit & 3, blk = (unit >> 2) & 63, b = unit >> 8, hq = g * 8 + wid;
        int nunit = unit, npass = pass, nch = ch + 1;
        if (nch == 2 && blk == 0) nch = 3;
        if (nch == 4 && blk == 63) nch = 5;
        const bool last_ch = nch >= 5;
        if (last_ch) { nch = 0; npass = pass + 1; if (npass == 2) { npass = 0; nunit = unit + G; } }
        const bool has_next = nunit < 512;
        if (ch == 0) {
            const float sk = g == 0 ? sk0 : g == 1 ? sk1 : g == 2 ? sk2 : sk3;
#pragma unroll
            for (int t = 0; t < 2; ++t) {
#pragma unroll
                for (int d0 = 0; d0 < 4; ++d0) qf[t][d0] = *(const LAS bf16x8*)(lds + QOFF + wid * 8192 + (t * 32 + r32) * 128 + (((2 * d0 + hi) ^ (r32 & 7)) * 16));
#pragma unroll
                for (int db = 0; db < 2; ++db)
#pragma unroll
                    for (int r = 0; r < 16; ++r) o[t][db][r] = 0.f;
                mx[t] = sk;
#pragma unroll
                for (int r = 0; r < 16; ++r) { nm[t][r] = -sk; la[t][r] = 1.f; }
            }
            LDS_WAIT();
        }
        if (has_next) { ATT_STAGE(nunit, nch, slot ^ 1); if (nch == 0) ATT_STAGE_Q(nunit, npass); }
        const LAS unsigned char* ks = lds + slot * SLOTB; const LAS unsigned char* vs = ks + VOFF;
        for (int kt = 0; kt < (ATT_MODE == 1 ? 0 : 4); ++kt) {
            bf16x8 kf[4];
#pragma unroll
            for (int d0 = 0; d0 < 4; ++d0) kf[d0] = *(const LAS bf16x8*)(ks + (kt * 32 + r32) * 128 + (((2 * d0 + hi) ^ (r32 & 7)) * 16));
            bf16x8 vf[2][2];
#pragma unroll
            for (int db = 0; db < 2; ++db)
#pragma unroll
                for (int s = 0; s < 2; ++s) vf[db][s] = *(const LAS bf16x8*)(vs + (db * 32 + r32) * 256 + (((kt * 4 + 2 * s + hi) ^ (r32 & 15)) * 16));
#pragma unroll
            for (int t = 0; t < 2; ++t) {
                const int qt = pass * 2 + t;
                if ((ch == 2 && kt < qt) || (ch == 4 && kt > qt)) continue;
                if (__any(la[t][0] > 65536.f)) {
                    const float pc = la[t][0], dl = __builtin_amdgcn_logf(pc), al = __builtin_amdgcn_rcpf(pc);
                    mx[t] += dl;
#pragma unroll
                    for (int r = 0; r < 16; ++r) { nm[t][r] = -mx[t]; la[t][r] *= al; }
#pragma unroll
                    for (int db = 0; db < 2; ++db)
#pragma unroll
                        for (int r = 0; r < 16; ++r) o[t][db][r] *= al;
                }
                f32x16 sacc;
                asm volatile("s_nop 1\n\tv_mfma_f32_32x32x16_bf16 %0, %1, %2, %3" : "=&v"(sacc) : "v"(kf[0]), "v"(qf[t][0]), "v"(nm[t]));
#pragma unroll
                for (int d0 = 1; d0 < 4; ++d0) sacc = __builtin_amdgcn_mfma_f32_32x32x16_bf16(kf[d0], qf[t][d0], sacc, 0, 0, 0);
                if ((ch == 2 || ch == 4) && kt == qt) {
#pragma unroll
                    for (int r = 0; r < 16; ++r) { const int j = crow(r, hi); const bool ok = ch == 2 ? (j >= r32) : (j <= r32); if (!ok) sacc[r] = -1e30f; }
                }
#pragma unroll
                for (int r = 0; r < 16; ++r) sacc[r] = __builtin_amdgcn_exp2f(sacc[r]);
                u32x4 p0, p1;
                p0.x = cvt_pk_bf16(sacc[0], sacc[1]); p0.y = cvt_pk_bf16(sacc[2], sacc[3]); p0.z = cvt_pk_bf16(sacc[4], sacc[5]); p0.w = cvt_pk_bf16(sacc[6], sacc[7]);
                p1.x = cvt_pk_bf16(sacc[8], sacc[9]); p1.y = cvt_pk_bf16(sacc[10], sacc[11]); p1.z = cvt_pk_bf16(sacc[12], sacc[13]); p1.w = cvt_pk_bf16(sacc[14], sacc[15]);
                const bf16x8 pf0 = __builtin_bit_cast(bf16x8, p0), pf1 = __builtin_bit_cast(bf16x8, p1);
#pragma unroll
                for (int s = 0; s < 2; ++s) {
#pragma unroll
                    for (int db = 0; db < 2; ++db) o[t][db] = __builtin_amdgcn_mfma_f32_32x32x16_bf16(vf[db][s], s == 0 ? pf0 : pf1, o[t][db], 0, 0, 0);
                    la[t] = __builtin_amdgcn_mfma_f32_32x32x16_bf16(ones, s == 0 ? pf0 : pf1, la[t], 0, 0, 0);
                }
            }
        }
        VM_WAIT();
        if (last_ch && nostore) {
#pragma unroll
            for (int t = 0; t < 2; ++t) {
                asm volatile("" :: "v"(la[t][0]), "v"(mx[t]));
#pragma unroll
                for (int db = 0; db < 2; ++db)
#pragma unroll
                    for (int r = 0; r < 16; ++r) asm volatile("" :: "v"(o[t][db][r]));
            }
        }
        if (last_ch && ATT_MODE == 0 && !nostore) {
#pragma unroll
            for (int t = 0; t < 2; ++t) {
                const float inv = 1.f / la[t][0];
                const size_t row = (size_t)b * SEQ + blk * 128 + (pass * 2 + t) * 32 + r32;
                const int ocol = hq * 64 + 8 * hi;
#pragma unroll
                for (int db = 0; db < 2; ++db)
#pragma unroll
                    for (int k = 0; k < 2; ++k) {
                        const int ra = 8 * k, rb = 8 * k + 4;
                        const unsigned a0 = cvt_pk_bf16(o[t][db][ra] * inv, o[t][db][ra + 1] * inv), a1 = cvt_pk_bf16(o[t][db][ra + 2] * inv, o[t][db][ra + 3] * inv);
                        const unsigned b0 = cvt_pk_bf16(o[t][db][rb] * inv, o[t][db][rb + 1] * inv), b1 = cvt_pk_bf16(o[t][db][rb + 2] * inv, o[t][db][rb + 3] * inv);
                        const auto s0 = __builtin_amdgcn_permlane32_swap(a0, b0, false, false), s1 = __builtin_amdgcn_permlane32_swap(a1, b1, false, false);
                        u32x4 w; w.x = s0[0]; w.y = s1[0]; w.z = s0[1]; w.w = s1[1];
                        *(u32x4*)(O + hb_off((int)row, ocol + db * 32 + k * 16)) = w;
                    }
            }
        }
        __builtin_amdgcn_s_barrier();
        if (!has_next) break;
        unit = nunit; pass = npass; ch = nch; slot ^= 1;
    }
#undef ATT_STAGE
#undef ATT_STAGE_Q
}

constexpr int RING_BYTES = 131072, MISC_OFF = RING_BYTES + 320, LDS_BYTES = 147456;
constexpr int NPHASE = 24;

__global__ void __launch_bounds__(512, 2) fwd_kernel(Params P) {
    extern __shared__ __attribute__((aligned(16))) unsigned char lds_raw[];
    LAS unsigned char* lds = (LAS unsigned char*)lds_raw;
    volatile LAS unsigned* MISC = (volatile LAS unsigned*)(lds + MISC_OFF);
    const int tid = threadIdx.x, lane = tid & 63, wave = __builtin_amdgcn_readfirstlane(tid >> 6);
    const int G = gridDim.x, bid = blockIdx.x, gw = bid * 8 + wave, NGW = G * 8;
    unsigned char* ws = P.ws;
    if (tid < 64) MISC[tid] = 0u;
    __syncthreads();
    XcdBarrier bar = xcd_barrier_post((unsigned*)(ws + WS_CTL) + CW_BAR, MISC + 8);

    float* MOD = (float*)(ws + WS_MOD); const float* mod0 = MOD; const float* mod1 = MOD + 3 * NMODC;
    bf16_t* XB = (bf16_t*)(ws + WS_XB); bf16_t* YB = (bf16_t*)(ws + WS_YB); float* XC = (float*)(ws + WS_XC); bf16_t* HB = (bf16_t*)(ws + WS_HB);
    unsigned char* GR = ws + WS_GR; bf16_t* Gb = (bf16_t*)GR;
    bf16_t* GBb = (bf16_t*)(GR + GR_GB); bf16_t* VBb = (bf16_t*)(GR + GR_VB); bf16_t* PT1 = (bf16_t*)(GR + GR_PTQ); bf16_t* UFb = (bf16_t*)(GR + GR_UF); bf16_t* T1b = (bf16_t*)(ws + WS_T1); bf16_t* PTQC = (bf16_t*)(GR + GR_PTQC);
    bf16_t* Qb = (bf16_t*)(GR + GR_Q); bf16_t* KBb = (bf16_t*)(GR + GR_KB); bf16_t* VTb = (bf16_t*)(GR + GR_VT);
    const float* ropec = (const float*)(ws + WS_ROPE); const float* ropes = ropec + 2048;
    float* SLAB = (float*)(ws + WS_SLAB);
    constexpr size_t TS2K = (size_t)256 * 2048 * 2, TSFF = (size_t)256 * FF * 2;

    const int lo = P.ph_lo, hi = P.ph_hi;
#define IN(k) (lo <= (k) && (k) < hi)
#define SEAM(k) do { if (IN(k) && IN((k) + 1)) xcd_barrier(bar); } while (0)
#define GEMM1(idx, nM_) do { pg8::SchedSimple S; S.A = (const char*)HB; S.Bt = (const char*)(ws + WS_W1I + (size_t)(idx) * W1I_BYTES); S.tstep = TS2K; S.nM = (nM_); S.nN = 44; S.G = G; S.c = bid; \
        pg8::EpiSwiglu E{Gb}; pg8::gemm_phase<pg8::EpiSwiglu, pg8::SchedSimple, true, true>(lds, 2048, pg8::lay_blk(), S, E); } while (0)
#define GEMM2(idx, NP, gatep) do { typedef pg8::SchedRes<TSFF, NP> SR; SR S; S.A = (const char*)Gb; S.Bt = (const char*)(ws + WS_W2T + (size_t)(idx) * W2T_BYTES); S.G = G; S.c = bid; \
        pg8::EpiY E{YB, (gatep), 0.5f, (bf16_t*)SLAB}; pg8::gemm_phase<pg8::EpiY, SR, true, true>(lds, FF, pg8::lay_blk(), S, E); } while (0)
#define GEMMO(wsoff, NP, gatep) do { typedef pg8::SchedRes<TS2K, NP> SR; SR S; S.A = (const char*)HB; S.Bt = (const char*)(ws + (wsoff)); S.G = G; S.c = bid; \
        pg8::EpiY E{YB, (gatep), 1.0f, (bf16_t*)SLAB}; pg8::gemm_phase<pg8::EpiY, SR, true, true>(lds, 2048, pg8::lay_blk(), S, E); } while (0)
#define LNC(lni, modn_, ish_, nparts_, srcC_) ln_ctx_phase((srcC_), (const bf16_t*)SLAB, (nparts_), XC, HB, P.ln_g + (lni) * D, P.ln_b + (lni) * D, (modn_), (ish_), (LAS float*)lds, bid, G, tid, lane, wave)

    if (IN(0)) { p0_prologue(P, lds, tid, lane, wave, bid, G); }
    SEAM(0);
    if (IN(1)) { if (NGW * 4 == SEQ) h0b_phase(P.x, P.ctx, mod0, HB, gw, NGW, lane); else h0_phase(P.x, P.ctx, mod0, HB, gw, NGW, lane); }
    SEAM(1);
    if (IN(2)) { GEMM1(0, NPT);
        if (bid >= 88) { LAS float* scr = (LAS float*)(lds + wave * 16384); const int sl = (bid - 88) * 8 + wave, ns = (G - 88) * 8;
            copy_range(P, scr, 2 * CP_MAT, 3 * CP_MAT, sl, ns, lane); copy_range(P, scr, CP_OTH0, CP_OTH1, sl, ns, lane); } }
    SEAM(2);
    if (IN(3)) { GEMM2(0, 11, mod0 + 2 * D); }
    SEAM(3);
    if (IN(4)) { if (NGW * 4 == SEQ) ln3_phase<true, false>(P.x, YB, XB, HB, P.ln_g, P.ln_b, mod0, 3, gw, NGW, lane); else ln2_phase<true, false>(P.x, YB, XB, HB, P.ln_g, P.ln_b, mod0, 3, gw, NGW, lane); LNC(0, mod0, 3, 11, P.ctx); }
    SEAM(4);
    if (IN(5)) { { pg8::SchedSimple S; S.A = (const char*)HB; S.Bt = (const char*)(ws + WS_WMI); S.tstep = TS2K; S.nM = NPT; S.nN = 16; S.G = G; S.c = bid;
          pg8::EpiMixIn E{GBb, VBb, UFb}; pg8::gemm_phase<pg8::EpiMixIn, pg8::SchedSimple, true, true>(lds, 2048, pg8::lay_blk(), S, E); }
        if (bid >= 32) { copy_range(P, (LAS float*)(lds + wave * 16384), 3 * CP_MAT, 6 * CP_MAT, (bid - 32) * 8 + wave, (G - 32) * 8, lane); } }
    SEAM(5);
    if (IN(6)) { { pg8::SchedCh S; S.CH = (const char*)(ws + WS_CH); S.UF = (const char*)UFb; S.G = G; S.c = bid;
          pg8::Lay L = pg8::lay_rm(1024); L.hstepB = 4 * 1024 * 2;
          pg8::EpiCh E{PT1}; pg8::gemm_phase<pg8::EpiCh, pg8::SchedCh, true, true>(lds, 256 + pg8::opaque0(), L, S, E); } }
    SEAM(6);
    if (IN(7)) { { pg8::SchedF1 S; S.A1 = (const char*)(ws + WS_A1); S.PT1 = (const char*)PT1; S.G = G; S.c = bid;
          pg8::EpiF1 E{T1b}; pg8::gemm_phase<pg8::EpiF1, pg8::SchedF1, true, true>(lds, 256 + pg8::opaque0(), pg8::lay_rm(256), S, E); }
        { pg8::SchedChC S; S.CH = (const char*)(ws + WS_CH); S.UF = (const char*)UFb; S.G = G; S.c = bid;
          pg8::EpiChC E{PTQC}; pg8::gemm_phase<pg8::EpiChC, pg8::SchedChC, true, true>(lds, 256 + pg8::opaque0(), pg8::lay_rm(1024), S, E); } }
    SEAM(7);
    if (IN(8)) { { pg8::SchedF2 S; S.A2M = (const char*)(ws + WS_A2M); S.T1 = (const char*)T1b; S.G = G; S.c = bid;
          pg8::EpiF2 E{HB, 1.f / 1024.f}; pg8::gemm_phase<pg8::EpiF2, pg8::SchedF2, true, true>(lds, 512 + pg8::opaque0(), pg8::lay_rm(512), S, E); }
        { pg8::SchedDftC S; S.ACTX = (const char*)(ws + WS_ACTX); S.PTQC = (const char*)PTQC; S.tstep = (size_t)256 * 512 * 2; S.G = G; S.c = bid;
          pg8::EpiDft E{HB, 0.00552427172802f}; pg8::gemm_phase<pg8::EpiDft, pg8::SchedDftC, true, true>(lds, 512 + pg8::opaque0(), pg8::lay_rm(512), S, E); }
        if (NGW * 4 == SEQ) conv3_phase(GBb, VBb, P.ab_conv, HB, gw, NGW, lane); else conv_phase(GBb, VBb, P.ab_conv, HB, gw, NGW, lane); }
    SEAM(8);
    if (IN(9)) { GEMMO(WS_WMO, 4, mod0 + 5 * D); }
    SEAM(9);
#if PROBE == 100 || PROBE == 101
    if (IN(10)) { for (int rep = 0; rep < 5 + pg8::opaque0(); ++rep) { if (rep) xcd_barrier(bar);
        bf16_t* xd = rep ? (bf16_t*)(ws + WS_T1) : (bf16_t*)XB; bf16_t* hd = rep ? (bf16_t*)(ws + WS_GR) : HB;
        if (PROBE == 101) ln3_phase<false, false>(XB, YB, xd, hd, P.ln_g + D, P.ln_b + D, mod0, 6, gw, NGW, lane);
        else ln2_phase<false, false>(XB, YB, xd, hd, P.ln_g + D, P.ln_b + D, mod0, 6, gw, NGW, lane); }
#else
    if (IN(10)) { if (NGW * 4 == SEQ) ln3_phase<false, false>(XB, YB, XB, HB, P.ln_g + D, P.ln_b + D, mod0, 6, gw, NGW, lane); else ln2_phase<false, false>(XB, YB, XB, HB, P.ln_g + D, P.ln_b + D, mod0, 6, gw, NGW, lane);
#endif
 LNC(1, mod0, 6, 4, XC); }
    SEAM(10);
    if (IN(11)) { GEMM1(1, NPT);
        if (bid >= 88) { LAS float* scr = (LAS float*)(lds + wave * 16384); const int sl = (bid - 88) * 8 + wave, ns = (G - 88) * 8;
            copy_range(P, scr, 6 * CP_MAT, 8 * CP_MAT, sl, ns, lane); } }
    SEAM(11);
    if (IN(12)) { GEMM2(1, 11, mod0 + 8 * D); }
    SEAM(12);
    if (IN(13)) { if (NGW * 4 == SEQ) ln3_phase<false, false>(XB, YB, XB, HB, P.ln_g + 2 * D, P.ln_b + 2 * D, mod1, 0, gw, NGW, lane); else ln2_phase<false, false>(XB, YB, XB, HB, P.ln_g + 2 * D, P.ln_b + 2 * D, mod1, 0, gw, NGW, lane); LNC(2, mod1, 0, 11, XC); }
    SEAM(13);
    if (IN(14)) { GEMM1(2, NPT);
        if (bid >= 88) { LAS float* scr = (LAS float*)(lds + wave * 16384); const int sl = (bid - 88) * 8 + wave, ns = (G - 88) * 8;
            copy_range(P, scr, 8 * CP_MAT, 9 * CP_MAT, sl, ns, lane); copy_range(P, scr, CP_OTH1, CP_NITEMS, sl, ns, lane); } }
    SEAM(14);
    if (IN(15)) { GEMM2(2, 11, mod1 + 2 * D); }
    SEAM(15);
    if (IN(16)) { if (NGW * 4 == SEQ) ln3_phase<false, false>(XB, YB, XB, HB, P.ln_g + 3 * D, P.ln_b + 3 * D, mod1, 3, gw, NGW, lane); else ln2_phase<false, false>(XB, YB, XB, HB, P.ln_g + 3 * D, P.ln_b + 3 * D, mod1, 3, gw, NGW, lane); LNC(3, mod1, 3, 11, XC); }
    SEAM(16);
    if (IN(17)) { { pg8::SchedAttnIn S; S.HB = (const char*)HB; S.WQKV = (const char*)(ws + WS_WQKV); S.tstep = TS2K; S.G = G; S.c = bid;
          pg8::EpiAttnIn E{Qb, KBb, VTb, ropec, ropes}; pg8::gemm_phase<pg8::EpiAttnIn, pg8::SchedAttnIn, true, true>(lds, 2048, pg8::lay_blk(), S, E); }
          if (bid >= 132) { copy_range(P, (LAS float*)(lds + wave * 16384), 9 * CP_MAT, 10 * CP_MAT, (bid - 132) * 8 + wave, (G - 132) * 8, lane); } }
    SEAM(17);
#if PROBE == 180 || PROBE == 181
    if (IN(18)) { for (int rep = 0; rep < 5 + pg8::opaque0(); ++rep) { if (rep) xcd_barrier(bar); attn_phase(lds, Qb, KBb, VTb, P.at_sink, HB, bid, G, tid, PROBE == 181 && rep > 0); } }
#else
    if (IN(18)) { attn_phase(lds, Qb, KBb, VTb, P.at_sink, HB, bid, G, tid); }
#endif
#if PROBE > 180 && PROBE < 200
    if (IN(18)) { for (int rep = 0; rep < 4 + pg8::opaque0(); ++rep) { xcd_barrier(bar); attn_phase<PROBE >= 190 ? PROBE - 190 : 0>(lds, Qb, KBb, VTb, P.at_sink, HB, bid, G, tid); } }
#endif
    SEAM(18);
    if (IN(19)) { GEMMO(WS_WO, 0, mod1 + 5 * D); }
    SEAM(19);
    if (IN(20)) { if (NGW * 4 == SEQ) ln3_phase<false, false>(XB, YB, XB, HB, P.ln_g + 4 * D, P.ln_b + 4 * D, mod1, 6, gw, NGW, lane); else ln2_phase<false, false>(XB, YB, XB, HB, P.ln_g + 4 * D, P.ln_b + 4 * D, mod1, 6, gw, NGW, lane); }
    SEAM(20);
    if (IN(21)) { GEMM1(3, NPL);
        if (bid >= 128) { copy_range(P, (LAS float*)(lds + wave * 16384), 11 * CP_MAT, 12 * CP_MAT, (bid - 128) * 8 + wave, (G - 128) * 8, lane); } }
    SEAM(21);
    if (IN(22)) { GEMM2(3, 0, mod1 + 8 * D); }
    SEAM(22);
    if (IN(23)) { if (NGW * 4 == SEQ) ln3_phase<false, true>(XB, YB, P.out, (bf16_t*)nullptr, P.ln_g + 5 * D, P.ln_b + 5 * D, mod1, 0, gw, NGW, lane); else ln2_phase<false, true>(XB, YB, P.out, (bf16_t*)nullptr, P.ln_g + 5 * D, P.ln_b + 5 * D, mod1, 0, gw, NGW, lane); }
#undef IN
#undef SEAM
#undef GEMM1
#undef GEMM2
#undef GEMMO
#undef LNC
}

extern "C" void kernel_launch(void* const* d_in, const int* in_sizes, int n_in, void* d_out, int out_size, void* d_ws, size_t ws_size, hipStream_t stream) {
    static int grid = 0;
    if (grid == 0) {
        if (n_in != 17 || ws_size < WS_END) { fprintf(stderr, "kernel_launch: n_in %d ws %zu (need %zu)\n", n_in, ws_size, (size_t)WS_END); grid = -1; return; }
        int dev = 0, cus = 0, per_cu = 0;
        if (hipGetDevice(&dev) != hipSuccess || hipDeviceGetAttribute(&cus, hipDeviceAttributeMultiprocessorCount, dev) != hipSuccess) { grid = -1; return; }
        if (hipFuncSetAttribute((const void*)fwd_kernel, hipFuncAttributeMaxDynamicSharedMemorySize, LDS_BYTES) != hipSuccess) { fprintf(stderr, "kernel_launch: hipFuncSetAttribute failed\n"); grid = -1; return; }
        if (hipOccupancyMaxActiveBlocksPerMultiprocessor(&per_cu, (const void*)fwd_kernel, 512, LDS_BYTES) != hipSuccess || per_cu < 1) { fprintf(stderr, "kernel_launch: occupancy query says %d\n", per_cu); }
        (void)hipGetLastError();
        grid = cus;
    }
    if (grid < 0) return;
    if (hipMemsetAsync((char*)d_ws + WS_CTL, 0, CTL_ZERO_BYTES, stream) != hipSuccess) return;
    Params p{};
    p.x = (const float*)d_in[0]; p.c = (const float*)d_in[1]; p.ctx = (const float*)d_in[2]; p.c_ctx = (const float*)d_in[3]; p.w_mod = (const float*)d_in[4]; p.b_mod = (const float*)d_in[5];
    p.ln_g = (const float*)d_in[6]; p.ln_b = (const float*)d_in[7]; p.wg = (const float*)d_in[8]; p.wu = (const float*)d_in[9]; p.wd = (const float*)d_in[10];
    p.ab_in = (const float*)d_in[11]; p.ab_conv = (const float*)d_in[12]; p.ab_out = (const float*)d_in[13]; p.at_in = (const float*)d_in[14]; p.at_sink = (const float*)d_in[15]; p.at_out = (const float*)d_in[16];
    p.out = (float*)d_out; p.ws = (unsigned char*)d_ws; p.ph_lo = 0; p.ph_hi = NPHASE;
    hipLaunchKernelGGL(fwd_kernel, dim3(grid), dim3(512), LDS_BYTES, stream, p);
}
```

```cpp
#define PROBE 0
#include <hip/hip_runtime.h>
#include <cstdio>
#include <cstdint>

#define LAS __attribute__((address_space(3)))
#define GAS __attribute__((address_space(1)))
typedef unsigned short bf16_t;
typedef short bf16x8 __attribute__((ext_vector_type(8)));
typedef short s16x4 __attribute__((ext_vector_type(4)));
typedef float f32x4 __attribute__((ext_vector_type(4)));
typedef float f32x2 __attribute__((ext_vector_type(2)));
typedef float f32x16 __attribute__((ext_vector_type(16)));
typedef unsigned u32x4 __attribute__((ext_vector_type(4)));
typedef unsigned u32x2 __attribute__((ext_vector_type(2)));

constexpr int D = 2048, SEQ = 8192, CTXL = 256, FF = 5632, ML = 16384, MC = 512, MT = 16896, NMODC = 9 * 2048;
constexpr int NPL = ML / 256, NPT = MT / 256;
constexpr float ALPHA = 1.41421356237f, LN_EPS = 1e-5f, LOG2E = 1.4426950408889634f;
constexpr float QSCALE = 0.125f * 1.4426950408889634f;

constexpr size_t MiB = 1u << 20;
constexpr size_t WS_CTL = 0, CTL_ZERO_BYTES = 32 * 1024;
constexpr size_t WS_MOD = 1 * MiB;
constexpr size_t WS_ROPE = 2 * MiB;
constexpr size_t WS_ACTX = 3 * MiB;
constexpr size_t WS_A1 = 3 * MiB + 256 * 1024;

constexpr size_t WS_W1I = 4 * MiB;
constexpr size_t W1I_BYTES = (size_t)2 * FF * D * 2;
constexpr size_t WS_W2T = WS_W1I + 4 * W1I_BYTES;
constexpr size_t W2T_BYTES = (size_t)D * FF * 2;
constexpr size_t WS_WMI = WS_W2T + 4 * W2T_BYTES;
constexpr size_t WS_CH = WS_WMI + 16 * MiB;
constexpr size_t WS_WMO = WS_WMI + 20 * MiB;
constexpr size_t WS_WQKV = WS_WMO + 8 * MiB;
constexpr size_t WS_WO = WS_WQKV + 10 * MiB;
constexpr size_t WS_X = WS_WO + 8 * MiB;
constexpr size_t WS_XB = WS_X, WS_YB = WS_X + 64 * MiB, WS_XC = WS_X + 128 * MiB;
constexpr size_t WS_HB = WS_X + 132 * MiB;
constexpr size_t WS_GR = WS_HB + 66 * MiB;
constexpr size_t GR_GB = 0, GR_VB = 33 * MiB, GR_PTQ = 66 * MiB, GR_PTQC = 130 * MiB, GR_UF = 132 * MiB;
constexpr size_t GR_Q = 0, GR_KB = 64 * MiB, GR_VT = 73 * MiB;
constexpr size_t WS_T1 = WS_GR + 182 * MiB;
constexpr size_t WS_SLAB = WS_T1 + 64 * MiB;
constexpr size_t WS_A2M = WS_SLAB + 44 * MiB;
constexpr size_t WS_END = WS_A2M + 8 * MiB;
static_assert(WS_W2T == 180 * MiB && WS_X == 314 * MiB && WS_END == 810 * MiB, "ws map");
constexpr int CW_TMO = 0, CW_CODE = 1, CW_BAR = 4096;

#define RLX_AGENT __ATOMIC_RELAXED, __HIP_MEMORY_SCOPE_AGENT
#define LDS_WAIT() asm volatile("s_waitcnt lgkmcnt(0)" ::: "memory")
#define VM_WAIT() asm volatile("s_waitcnt vmcnt(0)" ::: "memory")
__device__ __forceinline__ unsigned cvt_pk_bf16(float lo, float hi) { unsigned r; asm volatile("v_cvt_pk_bf16_f32 %0, %1, %2" : "=v"(r) : "v"(lo), "v"(hi)); return r; }
__device__ __forceinline__ int vec_of_panel(int pm) { return pm < 32 ? 0 : (pm < 64 ? 1 : 2); }
__device__ __forceinline__ int tok_of_slot(int s) { return ((s >> 3) << 1) | ((s >> 2) & 1) | ((s & 3) << 6); }
__device__ __forceinline__ int slot_of_tok(int o) { return (((o >> 1) & 31) << 3) | ((o & 1) << 2) | (o >> 6); }
__device__ __forceinline__ int lds_img_byte(int r, int c) { const int st = (r >> 4) * 2 + (c >> 5), rr = r & 15, cc = c & 31, ob = rr * 64 + cc * 2; return st * 1024 + (ob ^ (((ob >> 9) & 1) << 5)); }
__device__ __forceinline__ size_t img_off(int row, int col, int K) { return (size_t)(row >> 8) * 256 * K + (size_t)(col >> 6) * 16384 + ((row >> 7) & 1) * 8192 + (lds_img_byte(row & 127, col & 63) >> 1); }
__device__ __forceinline__ size_t hb_off(int row, int col) { return img_off(row, col, 2048); }
__device__ __forceinline__ int vec_of_row(int r) { return r < SEQ ? 0 : (r < 2 * SEQ ? 1 : 2); }
__device__ __forceinline__ float silu_f(float g) { return g * __builtin_amdgcn_rcpf(1.f + __builtin_amdgcn_exp2f(-g * LOG2E)); }
__device__ __forceinline__ f32x4 silu_mul4(f32x4 g, f32x4 u) {
    const f32x4 t = g * (-LOG2E); f32x4 e;
    e[0] = __builtin_amdgcn_exp2f(t[0]); e[1] = __builtin_amdgcn_exp2f(t[1]); e[2] = __builtin_amdgcn_exp2f(t[2]); e[3] = __builtin_amdgcn_exp2f(t[3]);
    const f32x4 d = e + 1.f; f32x4 r;
    r[0] = __builtin_amdgcn_rcpf(d[0]); r[1] = __builtin_amdgcn_rcpf(d[1]); r[2] = __builtin_amdgcn_rcpf(d[2]); r[3] = __builtin_amdgcn_rcpf(d[3]);
    return (g * u) * r;
}

namespace pg8 {
#define PG8_LAS __attribute__((address_space(3)))
constexpr int BM = 256, BK = 64, HALF = 128, HTB = HALF * BK * 2  , STAGE_BYTES = 8 * HTB, NXCD = 8, WGM = 8;
__host__ __device__ __forceinline__ int lds_byte(int r, int c) { const int st = (r >> 4) * 2 + (c >> 5), rr = r & 15, cc = c & 31, ob = rr * 64 + cc * 2; return st * 1024 + (ob ^ (((ob >> 9) & 1) << 5)); }
__host__ __device__ __forceinline__ void stage_rc(int b, int& R, int& C) { const int st = b / 1024, sb = b % 1024, swz = sb ^ (((sb >> 9) & 1) << 5); R = (st >> 1) * 16 + swz / 64; C = (st & 1) * 32 + (swz % 64) / 2; }
__host__ __device__ __forceinline__ int perm32(int rho) { const int n = rho >> 4, i = rho & 15; return 8 * (i >> 2) + 4 * n + (i & 3); }

struct Unit { int pm, pn, am, bn, kind; };
struct Lay { int rs; unsigned kstep, hstep, hstepB; };
__device__ __forceinline__ Lay lay_rm(int ld) { Lay l; l.rs = ld; l.kstep = 128u; l.hstep = (unsigned)(HALF * ld * 2); l.hstepB = l.hstep; return l; }
__device__ __forceinline__ Lay lay_blk() { Lay l; l.rs = -1; l.kstep = 32768u; l.hstep = 16384u; l.hstepB = 16384u; return l; }
__host__ __device__ __forceinline__ void map_tile(int L, int nM, int nN, int& pm, int& pn) {
    const int nwg = nM * nN; int wgid = L; { const int q = nwg / NXCD, r = nwg % NXCD, xcd = wgid % NXCD, off = wgid / NXCD; wgid = (xcd < r ? xcd * (q + 1) : r * (q + 1) + (xcd - r) * q) + off; }
    const int nig = WGM * nN, gid = wgid / nig, fm = gid * WGM, gsz = (nM - fm) < WGM ? (nM - fm) : WGM;
    pm = fm + ((wgid % nig) % gsz); pn = (wgid % nig) / gsz;
}

__device__ __forceinline__ int opaque0() { int z = 0; asm volatile("" : "+s"(z)); return z; }
struct SchedBase {
    __device__ __forceinline__ int ktiles(const Unit&, int K) const { return K / BK; }
    __device__ __forceinline__ void a_ready(const Unit&) const {}
    __device__ __forceinline__ void done(const Unit&) const {}
};
struct SchedSimple : SchedBase {
    const char* A; const char* Bt; size_t tstep; int nM, nN, G, c;
    __device__ __forceinline__ bool next(int i, Unit& u) const {
        const int nwg = nM * nN, nfull = nwg / G; int ii = i;
        if (nfull >= 4 && i < nfull) { ii = i + ((c & 7) * 3) % nfull; if (ii >= nfull) ii -= nfull; }
        const long L = (long)ii * G + c; if (L >= (long)nwg) return false; map_tile((int)L, nM, nN, u.pm, u.pn); u.am = u.pm; u.bn = u.pn; u.kind = 0; return true; }
    __device__ __forceinline__ const char* a_ptr(const Unit& u) const { return A + (size_t)u.am * tstep; }
    __device__ __forceinline__ const char* b_ptr(const Unit& u) const { return Bt + (size_t)u.bn * tstep; }
};
template <size_t TSTEP, int NPARTS>
struct SchedRes : SchedBase {
    const char* A; const char* Bt; int G, c;
    __device__ __forceinline__ bool next(int i, Unit& u) const {
        if (i > 2 || (i == 2 && c >= 16 * NPARTS)) return false;
        const bool lat = i < 2; int pm, pn; map_tile((lat ? i : 0) * G + c, NPL, 8, pm, pn);
        u.kind = lat ? -1 : (c >> 4); u.pm = lat ? pm : NPL + ((c >> 3) & 1); u.pn = lat ? pn : (c & 7); u.am = u.pm; u.bn = u.pn; return true;
    }
    __device__ __forceinline__ int ktiles(const Unit& u, int K) const { return u.kind < 0 ? K / BK : 8; }
    __device__ __forceinline__ const char* a_ptr(const Unit& u) const { return A + (size_t)u.am * TSTEP + (u.kind < 0 ? (size_t)0 : (size_t)u.kind * (8 * 32768)); }
    __device__ __forceinline__ const char* b_ptr(const Unit& u) const { return Bt + (size_t)u.bn * TSTEP + (u.kind < 0 ? (size_t)0 : (size_t)u.kind * (8 * 32768)); }
};
struct SchedCh : SchedBase {
    const char* CH; const char* UF; int G, c;
    __device__ __forceinline__ bool next(int i, Unit& u) const {
        const long L = (long)i * G + c; if (L >= 512) return false;
        const int x = (int)L; u.am = x & 1; u.bn = (x >> 1) & 3; u.pn = (x >> 3) & 31; u.kind = x >> 8; u.pm = 2 * u.bn + u.am; return true;
    }
    __device__ __forceinline__ const char* a_ptr(const Unit& u) const { return CH + (size_t)u.am * ((size_t)256 * 1024 * 2); }
    __device__ __forceinline__ const char* b_ptr(const Unit& u) const { return UF + ((size_t)u.kind * SEQ + 8 * (u.pn >> 2) + 2048 * (u.pn & 3)) * 2048 + (size_t)u.bn * 512; }
};
struct SchedChC : SchedBase {
    const char* CH; const char* UF; int G, c;
    __device__ __forceinline__ bool next(int i, Unit& u) const {
        const long L = (long)i * G + c; if (L >= 16) return false;
        const int x = (int)L; u.am = (x >> 1) & 1; u.bn = x >> 2; u.pn = NPL + (x & 1); u.pm = 2 * u.bn + u.am; u.kind = 1; return true;
    }
    __device__ __forceinline__ const char* a_ptr(const Unit& u) const { return CH + (size_t)u.am * ((size_t)256 * 1024 * 2); }
    __device__ __forceinline__ const char* b_ptr(const Unit& u) const { return UF + (size_t)u.pn * ((size_t)256 * 1024 * 2) + (size_t)u.bn * 512; }
};
struct SchedAttnIn : SchedBase {
    const char* HB; const char* WQKV; size_t tstep; int G, c;
    __device__ __forceinline__ bool next(int i, Unit& u) const {
        const long L = (long)i * G + c;
        if (L < 576) { map_tile((int)L, 64, 9, u.pm, u.pn); u.kind = 0; }
        else if (L < 642) { u.pm = 0; u.pn = (int)L - 576; u.kind = 1; }
        else if (L < 644) { u.pm = 64 + ((int)L - 642); u.pn = 8; u.kind = 0; }
        else return false;
        u.am = u.pm; u.bn = u.pn; return true;
    }
    __device__ __forceinline__ const char* a_ptr(const Unit& u) const { return u.kind == 0 ? HB + (size_t)u.am * tstep : WQKV + (size_t)9 * tstep; }
    __device__ __forceinline__ const char* b_ptr(const Unit& u) const { return (u.kind == 0 ? WQKV : HB) + (size_t)u.bn * tstep; }
};
struct SchedF1 : SchedBase {
    const char* A1; const char* PT1; int G, c;
    __device__ __forceinline__ bool next(int i, Unit& u) const {
        const long L = (long)i * G + c; if (L >= 512) return false;
        u.kind = (int)L >> 8; u.pn = (int)L & 255; u.pm = 0; u.am = opaque0(); u.bn = u.pn; return true;
    }
    __device__ __forceinline__ const char* a_ptr(const Unit& u) const { return A1 + (size_t)u.am * 64; }
    __device__ __forceinline__ const char* b_ptr(const Unit& u) const { return PT1 + (size_t)u.kind * ((size_t)65536 * 256 * 2) + (size_t)u.bn * ((size_t)256 * 256 * 2); }
};
struct SchedF2 : SchedBase {
    const char* A2M; const char* T1; int G, c;
    __device__ __forceinline__ bool next(int i, Unit& u) const {
        const long L = (long)i * G + c; if (L >= 256) return false;
        u.kind = (int)L >> 7; u.am = ((int)L & 127) >> 2; u.bn = (int)L & 3; u.pm = 0; u.pn = u.bn; return true;
    }
    __device__ __forceinline__ const char* a_ptr(const Unit& u) const { return A2M + (size_t)u.am * ((size_t)256 * 512 * 2); }
    __device__ __forceinline__ const char* b_ptr(const Unit& u) const { return T1 + ((size_t)(u.kind * 32 + u.am) * 1024 + (size_t)u.bn * 256) * (512 * 2); }
};
struct SchedDftC : SchedBase {
    const char* ACTX; const char* PTQC; size_t tstep; int G, c;
    __device__ __forceinline__ bool next(int i, Unit& u) const {
        const long L = (long)i * G + c; if (L >= 8) return false;
        u.kind = (int)L >> 2; u.am = opaque0(); u.bn = (int)L & 3; u.pm = 64 + u.kind; u.pn = u.bn; return true;
    }
    __device__ __forceinline__ const char* a_ptr(const Unit& u) const { return ACTX + (size_t)u.am * 64; }
    __device__ __forceinline__ const char* b_ptr(const Unit& u) const { return PTQC + (size_t)u.kind * ((size_t)2048 * 256 * 2) + (size_t)u.bn * tstep; }
};

typedef f32x4 AccT[2][2][4][2];

struct EpiSwiglu {
    static constexpr bool PERM = true, AFTER_DRAIN = false; static constexpr int BMAP = 0;
    bf16_t* G;
    __device__ __forceinline__ void operator()(const AccT& acc, const Unit& u, int wr, int wc, int fr, int fq) const {
        const int rr0 = wr * 64 + fr, col0 = u.pn * 128 + wc * 32 + 8 * fq;
        const int grow0 = u.pm * BM + rr0;
#pragma unroll
        for (int ai = 0; ai < 2; ++ai)
#pragma unroll
            for (int m = 0; m < 4; ++m) {
                bf16_t* rowp = G + img_off(grow0 + ai * HALF + m * 16, col0, FF);
                const f32x4 g0 = acc[ai][0][m][0], g1 = acc[ai][0][m][1], u0 = acc[ai][1][m][0], u1 = acc[ai][1][m][1];
                const f32x4 v0 = silu_mul4(g0, u0), v1 = silu_mul4(g1, u1);
                u32x4 w; w.x = cvt_pk_bf16(v0[0], v0[1]); w.y = cvt_pk_bf16(v0[2], v0[3]); w.z = cvt_pk_bf16(v1[0], v1[1]); w.w = cvt_pk_bf16(v1[2], v1[3]);
                *(u32x4*)rowp = w;
            }
    }
};
struct EpiY {
    static constexpr bool PERM = true, AFTER_DRAIN = false; static constexpr int BMAP = 0;
    bf16_t* YB; const float* gate; float ysc;
    bf16_t* YC;
    __device__ __forceinline__ void operator()(const AccT& acc, const Unit& u, int wr, int wc, int fr, int fq) const {
        const int row0 = u.pm * BM + wr * 64 + fr, col0 = u.pn * BM + wc * 32 + 8 * fq;
        const float* gp = gate + (size_t)vec_of_panel(u.pm) * NMODC + col0;
        bf16_t* ybase = u.kind < 0 ? YB : YC + ((size_t)u.kind * MC - ML) * D;
        f32x4 gv[2][2];
#pragma unroll
        for (int bj = 0; bj < 2; ++bj)
#pragma unroll
            for (int n = 0; n < 2; ++n) gv[bj][n] = *(const f32x4*)(gp + bj * HALF + n * 4) * ysc;
#pragma unroll
        for (int ai = 0; ai < 2; ++ai)
#pragma unroll
            for (int m = 0; m < 4; ++m) {
                bf16_t* rowp = ybase + (size_t)(row0 + ai * HALF + m * 16) * D + col0;
#pragma unroll
                for (int bj = 0; bj < 2; ++bj) {
                    const f32x4 v0 = acc[ai][bj][m][0] * gv[bj][0], v1 = acc[ai][bj][m][1] * gv[bj][1];
                    u32x4 w; w.x = cvt_pk_bf16(v0[0], v0[1]); w.y = cvt_pk_bf16(v0[2], v0[3]); w.z = cvt_pk_bf16(v1[0], v1[1]); w.w = cvt_pk_bf16(v1[2], v1[3]);
                    *(u32x4*)(rowp + bj * HALF) = w;
                }
            }
    }
};
struct EpiMixIn {
    static constexpr bool PERM = true, AFTER_DRAIN = false; static constexpr int BMAP = 0;
    bf16_t* GB; bf16_t* VB; bf16_t* UF;
    __device__ __forceinline__ void operator()(const AccT& acc, const Unit& u, int wr, int wc, int fr, int fq) const {
        const int rs0 = wr * 64 + fr, cl = wc * 32 + 8 * fq;
#pragma unroll
        for (int ai = 0; ai < 2; ++ai)
#pragma unroll
            for (int m = 0; m < 4; ++m) {
                const int rs = rs0 + ai * HALF + m * 16; const size_t row = (size_t)u.pm * BM + rs;
                if (u.pn >= 4 && u.pn < 12) {
                    const f32x4 v0 = acc[ai][0][m][0] * acc[ai][1][m][0], v1 = acc[ai][0][m][1] * acc[ai][1][m][1];
                    u32x4 w; w.x = cvt_pk_bf16(v0[0], v0[1]); w.y = cvt_pk_bf16(v0[2], v0[3]); w.z = cvt_pk_bf16(v1[0], v1[1]); w.w = cvt_pk_bf16(v1[2], v1[3]);
                    *(u32x4*)(VB + row * 1024 + (u.pn - 4) * 128 + cl) = w;
                } else {
                    bf16_t* dst = u.pn < 4 ? GB + row * 1024 + u.pn * 256 + cl : UF + row * 1024 + (u.pn - 12) * 256 + cl;
#pragma unroll
                    for (int bj = 0; bj < 2; ++bj) {
                        const f32x4 v0 = acc[ai][bj][m][0], v1 = acc[ai][bj][m][1];
                        u32x4 w; w.x = cvt_pk_bf16(v0[0], v0[1]); w.y = cvt_pk_bf16(v0[2], v0[3]); w.z = cvt_pk_bf16(v1[0], v1[1]); w.w = cvt_pk_bf16(v1[2], v1[3]);
                        *(u32x4*)(dst + bj * HALF) = w;
                    }
                }
            }
    }
};
struct EpiCh {
    static constexpr bool PERM = true, AFTER_DRAIN = false; static constexpr int BMAP = 1;
    bf16_t* PT1;
    __device__ __forceinline__ void operator()(const AccT& acc, const Unit& u, int wr, int wc, int fr, int fq) const {
        const int rs0 = wr * 64 + fr, q = u.pn >> 2, r = u.pn & 3;
        bf16_t* base = PT1 + (size_t)u.kind * ((size_t)65536 * 256) + 32 * r + 8 * fq;
#pragma unroll
        for (int ai = 0; ai < 2; ++ai)
#pragma unroll
            for (int m = 0; m < 4; ++m) {
                const int w = u.pm * BM + rs0 + ai * HALF + m * 16, col = w >> 1, s = w & 1;
#pragma unroll
                for (int bj = 0; bj < 2; ++bj) {
                    const int n1 = 8 * q + 4 * bj + wc; const f32x4 v0 = acc[ai][bj][m][0], v1 = acc[ai][bj][m][1];
                    u32x4 pk; pk.x = cvt_pk_bf16(v0[0], v0[1]); pk.y = cvt_pk_bf16(v0[2], v0[3]); pk.z = cvt_pk_bf16(v1[0], v1[1]); pk.w = cvt_pk_bf16(v1[2], v1[3]);
                    *(u32x4*)(base + ((size_t)(col * 64 + n1) * 2 + s) * 128) = pk;
                }
            }
    }
};
struct EpiChC {
    static constexpr bool PERM = true, AFTER_DRAIN = false; static constexpr int BMAP = 0;
    bf16_t* PTQC;
    __device__ __forceinline__ void operator()(const AccT& acc, const Unit& u, int wr, int wc, int fr, int fq) const {
        const int rs0 = wr * 64 + fr, cl = wc * 32 + 8 * fq;
        bf16_t* base = PTQC + (size_t)(u.pn - NPL) * ((size_t)2048 * 256);
#pragma unroll
        for (int ai = 0; ai < 2; ++ai)
#pragma unroll
            for (int m = 0; m < 4; ++m) {
                bf16_t* rowp = base + (size_t)(u.pm * BM + rs0 + ai * HALF + m * 16) * 256 + cl;
#pragma unroll
                for (int bj = 0; bj < 2; ++bj) {
                    const f32x4 v0 = acc[ai][bj][m][0], v1 = acc[ai][bj][m][1];
                    u32x4 w; w.x = cvt_pk_bf16(v0[0], v0[1]); w.y = cvt_pk_bf16(v0[2], v0[3]); w.z = cvt_pk_bf16(v1[0], v1[1]); w.w = cvt_pk_bf16(v1[2], v1[3]);
                    *(u32x4*)(rowp + bj * HALF) = w;
                }
            }
    }
};
struct EpiF1 {
    static constexpr bool PERM = true, AFTER_DRAIN = false; static constexpr int BMAP = 0;
    bf16_t* T1;
    __device__ __forceinline__ void operator()(const AccT& acc, const Unit& u, int wr, int wc, int fr, int fq) const {
        const int n10 = 32 * (wc & 1) + 8 * fq + u.am;
#pragma unroll
        for (int ai = 0; ai < 2; ++ai)
#pragma unroll
            for (int m = 0; m < 4; ++m) {
                const int k2 = wr * 64 + m * 16 + fr + u.am;
#pragma unroll
                for (int bj = 0; bj < 2; ++bj) {
                    const int col = 4 * u.pn + 2 * bj + (wc >> 1);
                    const f32x4 v0 = acc[ai][bj][m][0], v1 = acc[ai][bj][m][1];
                    u32x4 w; w.x = cvt_pk_bf16(v0[0], v0[1]); w.y = cvt_pk_bf16(v0[2], v0[3]); w.z = cvt_pk_bf16(v1[0], v1[1]); w.w = cvt_pk_bf16(v1[2], v1[3]);
                    *(u32x4*)(T1 + (((((size_t)u.kind * 32 + (k2 >> 2)) * 1024 + col) * 4 + (k2 & 3)) * 2 + ai) * 64 + n10) = w;
                }
            }
    }
};
struct EpiF2 {
    static constexpr bool PERM = true, AFTER_DRAIN = false; static constexpr int BMAP = 0;
    bf16_t* A2; float norm;
    __device__ __forceinline__ void operator()(const AccT& acc, const Unit& u, int wr, int wc, int fr, int fq) const {
        const int col0 = 1024 + u.bn * 256 + wc * 32 + 8 * fq;
#pragma unroll
        for (int ai = 0; ai < 2; ++ai)
#pragma unroll
            for (int m = 0; m < 4; ++m) {
                const int k = 4 * u.am + 2 * ai + wr + 128 * (16 * m + fr);
                bf16_t* rowp = A2 + hb_off(u.kind * SEQ + k, col0);
#pragma unroll
                for (int bj = 0; bj < 2; ++bj) {
                    const f32x4 v0 = acc[ai][bj][m][0] * norm, v1 = acc[ai][bj][m][1] * norm;
                    u32x4 w; w.x = cvt_pk_bf16(v0[0], v0[1]); w.y = cvt_pk_bf16(v0[2], v0[3]); w.z = cvt_pk_bf16(v1[0], v1[1]); w.w = cvt_pk_bf16(v1[2], v1[3]);
                    *(u32x4*)(rowp + bj * 2 * 16384) = w;
                }
            }
    }
};
struct EpiDft {
    static constexpr bool PERM = true, AFTER_DRAIN = false; static constexpr int BMAP = 0;
    bf16_t* A2; float norm;
    __device__ __forceinline__ void operator()(const AccT& acc, const Unit& u, int wr, int wc, int fr, int fq) const {
        const int row0 = u.pm * BM + wr * 64 + fr, col0 = 1024 + u.pn * 256 + wc * 32 + 8 * fq;
#pragma unroll
        for (int ai = 0; ai < 2; ++ai)
#pragma unroll
            for (int m = 0; m < 4; ++m) {
                bf16_t* rowp = A2 + hb_off(row0 + ai * HALF + m * 16, col0);
#pragma unroll
                for (int bj = 0; bj < 2; ++bj) {
                    const f32x4 v0 = acc[ai][bj][m][0] * norm, v1 = acc[ai][bj][m][1] * norm;
                    u32x4 w; w.x = cvt_pk_bf16(v0[0], v0[1]); w.y = cvt_pk_bf16(v0[2], v0[3]); w.z = cvt_pk_bf16(v1[0], v1[1]); w.w = cvt_pk_bf16(v1[2], v1[3]);
                    *(u32x4*)(rowp + bj * 2 * 16384) = w;
                }
            }
    }
};
struct EpiAttnIn {
    static constexpr bool PERM = false, AFTER_DRAIN = false; static constexpr int BMAP = 0;
    bf16_t* Q; bf16_t* KB; bf16_t* VT; const float* ropec; const float* ropes;
    __device__ __forceinline__ void operator()(const AccT& acc, const Unit& u, int wr, int wc, int fr, int fq) const {
        const int row0 = u.pm * BM + wr * 64 + fr, cl = wc * 32 + 4 * fq, cq = wc * 32 + 8 * fq;
        if (u.kind == 1) {
#pragma unroll
            for (int ai = 0; ai < 2; ++ai)
#pragma unroll
                for (int m = 0; m < 4; ++m) {
                    bf16_t* rowp = VT + (size_t)(wr * 64 + fr + ai * HALF + m * 16) * MT + u.pn * 256 + wc * 32 + 4 * (((fq & 1) << 1) | (fq >> 1));
#pragma unroll
                    for (int bj = 0; bj < 2; ++bj)
#pragma unroll
                        for (int n = 0; n < 2; ++n) { const f32x4 v = acc[ai][bj][m][n]; u32x2 w; w.x = cvt_pk_bf16(v[0], v[1]); w.y = cvt_pk_bf16(v[2], v[3]); *(u32x2*)(rowp + bj * HALF + n * 16) = w; }
                }
            return;
        }
        const bool isq = u.pn < 8, rope = u.pm < NPL;
        const float sc = isq ? QSCALE : 1.f;
        bf16_t* base = isq ? Q + u.pn * 256 : KB; const size_t ldc = isq ? 2048 : 256;
#pragma unroll
        for (int ai = 0; ai < 2; ++ai)
#pragma unroll
            for (int m = 0; m < 4; ++m) {
                const int r = row0 + ai * HALF + m * 16, pos = r & (SEQ - 1);
                const int p = (wc & 1) ? (pos & 63) : (pos >> 6);
                f32x4 cs = (f32x4){1.f, 1.f, 1.f, 1.f}, sn = (f32x4){0.f, 0.f, 0.f, 0.f};
                if (rope) { cs = *(const f32x4*)(ropec + p * 16 + 4 * fq); sn = *(const f32x4*)(ropes + p * 16 + 4 * fq); }
                bf16_t* rowp = base + (size_t)r * ldc + cq;
#pragma unroll
                for (int bj = 0; bj < 2; ++bj) {
                    const f32x4 x1 = acc[ai][bj][m][0], x2 = acc[ai][bj][m][1];
                    const f32x4 o1 = (x1 * cs - x2 * sn) * sc, o2 = (x2 * cs + x1 * sn) * sc;
                    u32x4 w; w.x = cvt_pk_bf16(o1[0], o1[1]); w.y = cvt_pk_bf16(o1[2], o1[3]); w.z = cvt_pk_bf16(o2[0], o2[1]); w.w = cvt_pk_bf16(o2[2], o2[3]);
                    *(u32x4*)(rowp + bj * HALF) = w;
                }
            }
    }
};

template <class Epi, class Sched, bool ALIGN_EPI = false, bool SP2 = false>
__device__ __forceinline__ void gemm_phase(PG8_LAS unsigned char* lds, const int K, const Lay lay, const Sched& S, const Epi& E) {
    const int tid = threadIdx.x, wid = __builtin_amdgcn_readfirstlane(tid >> 6), lane = tid & 63, wr = wid >> 2, wc = wid & 3, fr = lane & 15, fq = lane >> 4;

    unsigned voffA[2], voffB[2];
#pragma unroll
    for (int i = 0; i < 2; ++i) { int R, C; stage_rc(tid * 16 + i * 8192, R, C); const int Rb = Epi::BMAP == 1 ? ((R >> 5) + 64 * perm32(R & 31)) : (Epi::PERM ? ((R & ~31) + perm32(R & 31)) : R);
        if (lay.rs < 0) { voffA[i] = voffB[i] = (unsigned)(tid * 16 + i * 8192); } else { voffA[i] = (unsigned)(R * lay.rs + C) * 2u; voffB[i] = (unsigned)(Rb * lay.rs + C) * 2u; }     }
    const size_t kstep = lay.kstep; const size_t hstepB = lay.hstepB;
    const size_t hstep = lay.hstep;
    const unsigned ldsw = (unsigned)wid * 1024u;
    const int aoff = lds_byte(wr * 64 + fr, fq * 8), boff = lds_byte(wc * 32 + fr, fq * 8);
#define PG8_SA(b, h) (((b) * 2 + (h)) * HTB)
#define PG8_SB(b, h) ((4 + (b) * 2 + (h)) * HTB)
#define PG8_STAGE(bufoff, gbase, voff) do { _Pragma("unroll") for (int _i = 0; _i < 2; ++_i) \
        __builtin_amdgcn_global_load_lds((const unsigned*)((const char*)(gbase) + (voff)[_i]), (PG8_LAS unsigned*)(lds + (bufoff) + ldsw + _i * 8192), 16, 0, 0); } while (0)
#define PG8_LDA(dst, b, h) do { _Pragma("unroll") for (int m = 0; m < 4; ++m) _Pragma("unroll") for (int k = 0; k < 2; ++k) dst[m][k] = *(const PG8_LAS bf16x8*)(lds + PG8_SA(b, h) + aoff + m * 2048 + k * 1024); } while (0)
#define PG8_LDB(dst, b, h) do { _Pragma("unroll") for (int n = 0; n < 2; ++n) _Pragma("unroll") for (int k = 0; k < 2; ++k) dst[n][k] = *(const PG8_LAS bf16x8*)(lds + PG8_SB(b, h) + boff + n * 2048 + k * 1024); } while (0)
#define PG8_MMA(ai, bj, At, Bt) do { __builtin_amdgcn_s_setprio(1); _Pragma("unroll") for (int m = 0; m < 4; ++m) _Pragma("unroll") for (int n = 0; n < 2; ++n) _Pragma("unroll") for (int k = 0; k < 2; ++k) \
        acc[ai][bj][m][n] = __builtin_amdgcn_mfma_f32_16x16x32_bf16(Bt[n][k], At[m][k], acc[ai][bj][m][n], 0, 0, 0); __builtin_amdgcn_s_setprio(0); } while (0)
#define PG8_WAIT_V(n) asm volatile("s_waitcnt vmcnt(" #n ")" ::: "memory")
#define PG8_WAIT_L(n) asm volatile("s_waitcnt lgkmcnt(" #n ")" ::: "memory")
#define PG8_BAR __builtin_amdgcn_s_barrier()
#define PG8_SCHED __builtin_amdgcn_sched_barrier(0)
    Unit cur, nxt; int ui = 0;
    if (!S.next(0, cur)) return;
    int nt = S.ktiles(cur, K);
    AccT acc;
#pragma unroll
    for (int a = 0; a < 2; ++a)
#pragma unroll
        for (int b = 0; b < 2; ++b)
#pragma unroll
            for (int m = 0; m < 4; ++m)
#pragma unroll
                for (int n = 0; n < 2; ++n) acc[a][b][m][n] = (f32x4){0.f, 0.f, 0.f, 0.f};
    bf16x8 At[4][2], B0[2][2], B1[2][2];
    const char* cA = S.a_ptr(cur); const char* cB = S.b_ptr(cur);
    S.a_ready(cur);
    if constexpr (SP2) {
        PG8_STAGE(PG8_SB(0, 0), cB, voffB); PG8_STAGE(PG8_SB(0, 1), cB + hstepB, voffB); PG8_STAGE(PG8_SA(0, 0), cA, voffA); PG8_STAGE(PG8_SA(0, 1), cA + hstep, voffA);
        if (wr == 1) PG8_BAR;
        PG8_WAIT_V(2); PG8_BAR;
        PG8_STAGE(PG8_SB(1, 0), cB + kstep, voffB); PG8_STAGE(PG8_SA(1, 0), cA + kstep, voffA); PG8_STAGE(PG8_SB(1, 1), cB + hstepB + kstep, voffB);
        PG8_WAIT_V(6); PG8_BAR;
    } else {
        PG8_STAGE(PG8_SB(0, 0), cB, voffB); PG8_STAGE(PG8_SA(0, 0), cA, voffA); PG8_STAGE(PG8_SB(0, 1), cB + hstepB, voffB); PG8_STAGE(PG8_SA(0, 1), cA + hstep, voffA);
        if (wr == 1) PG8_BAR;
        PG8_WAIT_V(4); PG8_BAR;
        PG8_STAGE(PG8_SB(1, 0), cB + kstep, voffB); PG8_STAGE(PG8_SA(1, 0), cA + kstep, voffA); PG8_STAGE(PG8_SB(1, 1), cB + hstepB + kstep, voffB);
        PG8_WAIT_V(6); PG8_BAR;
    }
    for (;;) {
        const bool has_next = S.next(ui + 1, nxt);
        const char* nA = has_next ? S.a_ptr(nxt) : cA; const char* nB = has_next ? S.b_ptr(nxt) : cB;
        for (int t = 0; t < nt; t += 2) {
            const bool last = (t == nt - 2);
            const char* a1 = cA + (size_t)(t + 1) * kstep;
            const char* a2 = last ? nA : cA + (size_t)(t + 2) * kstep; const char* b2 = last ? nB : cB + (size_t)(t + 2) * kstep;
            const char* a3 = a2 + kstep; const char* b3 = b2 + kstep;
            if (last && has_next) S.a_ready(nxt);
            if constexpr (SP2) {
            PG8_LDB(B0, 0, 0); PG8_LDB(B1, 0, 1); PG8_SCHED; PG8_LDA(At, 0, 0); PG8_STAGE(PG8_SA(1, 1), a1 + hstep, voffA);
            PG8_WAIT_V(8); PG8_WAIT_L(0); PG8_BAR; PG8_MMA(0, 0, At, B0); PG8_MMA(0, 1, At, B1); PG8_BAR; PG8_SCHED;
            PG8_LDA(At, 0, 1); PG8_STAGE(PG8_SB(0, 0), b2, voffB); PG8_STAGE(PG8_SB(0, 1), b2 + hstepB, voffB); PG8_STAGE(PG8_SA(0, 0), a2, voffA);
            PG8_WAIT_V(8); PG8_WAIT_L(0); PG8_BAR; PG8_MMA(1, 0, At, B0); PG8_MMA(1, 1, At, B1); PG8_BAR; PG8_SCHED;
            PG8_LDB(B0, 1, 0); PG8_LDB(B1, 1, 1); PG8_SCHED; PG8_LDA(At, 1, 0); PG8_STAGE(PG8_SA(0, 1), a2 + hstep, voffA);
            PG8_WAIT_V(8); PG8_WAIT_L(0); PG8_BAR; PG8_MMA(0, 0, At, B0); PG8_MMA(0, 1, At, B1); PG8_BAR; PG8_SCHED;
            PG8_LDA(At, 1, 1); PG8_STAGE(PG8_SB(1, 0), b3, voffB); PG8_STAGE(PG8_SB(1, 1), b3 + hstepB, voffB); PG8_STAGE(PG8_SA(1, 0), a3, voffA);
            PG8_WAIT_V(8); PG8_WAIT_L(0); PG8_BAR; PG8_MMA(1, 0, At, B0); PG8_MMA(1, 1, At, B1); PG8_BAR; PG8_SCHED;
            } else {
            PG8_LDB(B0, 0, 0); PG8_SCHED; PG8_LDA(At, 0, 0); PG8_STAGE(PG8_SA(1, 1), a1 + hstep, voffA);
            PG8_WAIT_L(8); PG8_BAR; PG8_WAIT_L(0); PG8_MMA(0, 0, At, B0); PG8_BAR; PG8_SCHED;
            PG8_LDB(B1, 0, 1); PG8_STAGE(PG8_SB(0, 0), b2, voffB);
            PG8_BAR; PG8_WAIT_L(0); PG8_MMA(0, 1, At, B1); PG8_BAR;
            PG8_LDA(At, 0, 1); PG8_STAGE(PG8_SA(0, 0), a2, voffA);
            PG8_BAR; PG8_WAIT_L(0); PG8_MMA(1, 0, At, B0); PG8_BAR; PG8_SCHED;
            PG8_STAGE(PG8_SB(0, 1), b2 + hstepB, voffB);
            PG8_WAIT_V(6); PG8_BAR; PG8_MMA(1, 1, At, B1); PG8_BAR;
            PG8_LDB(B0, 1, 0); PG8_SCHED; PG8_LDA(At, 1, 0); PG8_STAGE(PG8_SA(0, 1), a2 + hstep, voffA);
            PG8_WAIT_L(8); PG8_BAR; PG8_WAIT_L(0); PG8_MMA(0, 0, At, B0); PG8_BAR; PG8_SCHED;
            PG8_LDB(B1, 1, 1); PG8_STAGE(PG8_SB(1, 0), b3, voffB);
            PG8_BAR; PG8_WAIT_L(0); PG8_MMA(0, 1, At, B1); PG8_BAR;
            PG8_LDA(At, 1, 1); PG8_STAGE(PG8_SA(1, 0), a3, voffA);
            PG8_BAR; PG8_WAIT_L(0); PG8_MMA(1, 0, At, B0); PG8_BAR; PG8_SCHED;
            PG8_STAGE(PG8_SB(1, 1), b3 + hstepB, voffB);
            PG8_WAIT_V(6); PG8_BAR; PG8_MMA(1, 1, At, B1); PG8_BAR;
            }
        }
        if constexpr (ALIGN_EPI) { if (wr == 0) PG8_BAR; }
        if constexpr (!Epi::AFTER_DRAIN) { E(acc, cur, wr, wc, fr, fq); S.done(cur); }
        if (!has_next) break;
#pragma unroll
        for (int a = 0; a < 2; ++a)
#pragma unroll
            for (int b = 0; b < 2; ++b)
#pragma unroll
                for (int m = 0; m < 4; ++m)
#pragma unroll
                    for (int n = 0; n < 2; ++n) acc[a][b][m][n] = (f32x4){0.f, 0.f, 0.f, 0.f};
        cur = nxt; cA = nA; cB = nB; ++ui; nt = S.ktiles(cur, K);
        if constexpr (ALIGN_EPI) { if (wr == 1) PG8_BAR; }
    }
    PG8_WAIT_V(0);
    if constexpr (!ALIGN_EPI) { if (wr == 0) PG8_BAR; }
    PG8_BAR;
    if constexpr (Epi::AFTER_DRAIN) { E.fused(acc, cur, wr, wc, fr, fq, lds, wid, lane); S.done(cur); }
#undef PG8_SA
#undef PG8_SB
#undef PG8_STAGE
#undef PG8_LDA
#undef PG8_LDB
#undef PG8_MMA
#undef PG8_WAIT_V
#undef PG8_WAIT_L
#undef PG8_BAR
#undef PG8_SCHED
}
}

#define XB_TMO      128
#define XB_XCNT(j)  (256  + 64 * (j))
#define XB_XSUB(j)  (1280 + 64 * (j))
#define XB_XGEN(j)  (2304 + 64 * (j))
#define XB_TOP      3328
#define XB_TOPGEN   3392
#define XCD_BAR_WORDS 3456
#define XB_SPIN_CAP (1u << 18)

__device__ __forceinline__ unsigned xb_ld(unsigned* p)              { return __hip_atomic_load(p, __ATOMIC_RELAXED, __HIP_MEMORY_SCOPE_AGENT); }
__device__ __forceinline__ unsigned xb_add(unsigned* p, unsigned v) { return __hip_atomic_fetch_add(p, v, __ATOMIC_RELAXED, __HIP_MEMORY_SCOPE_AGENT); }
__device__ __forceinline__ unsigned xb_xcc_id() { return (unsigned)__builtin_amdgcn_s_getreg((3 << 11) | 20) & 0xFu; }
#define XB_SPIN(cond, bar) do { unsigned _sp = 0; while (cond) { __builtin_amdgcn_s_sleep(1); \
    if ((++_sp & 255u) == 0u) { if (xb_ld(&(bar)[XB_TMO])) break; if (_sp > XB_SPIN_CAP) { atomicAdd(&(bar)[XB_TMO], 1u); break; } } } } while (0)

struct XcdBarrier {
    unsigned* bar; unsigned x;
    volatile LAS unsigned* st;
};

__device__ __forceinline__ XcdBarrier xcd_barrier_post(unsigned* bar, volatile LAS unsigned* st) {
    XcdBarrier b; b.bar = bar; b.x = xb_xcc_id(); b.st = st;
    if (threadIdx.x == 0) (void)xb_add(&bar[XB_XCNT(b.x)], 1u);
    return b;
}
__device__ __forceinline__ void xcd_barrier_complete(unsigned* bar, unsigned x, unsigned& nloc, unsigned& nx) {
    const unsigned G = gridDim.x * gridDim.y * gridDim.z;
    unsigned sum, cnt, mine, sp = 0u;
    for (;;) {
        sum = 0u; cnt = 0u; mine = 0u;
#pragma unroll
        for (unsigned j = 0; j < 16; ++j) { const unsigned c = xb_ld(&bar[XB_XCNT(j)]); sum += c; cnt += (c > 0u) ? 1u : 0u; mine = (j == x) ? c : mine; }
        if (sum == G) break;
        __builtin_amdgcn_s_sleep(1);
        if ((++sp & 255u) == 0u) { if (xb_ld(&bar[XB_TMO])) break; if (sp > XB_SPIN_CAP) { atomicAdd(&bar[XB_TMO], 1u); break; } }
    }
    nloc = mine > 0u ? mine : 1u; nx = cnt > 0u ? cnt : 1u;
}

__device__ __forceinline__ void xcd_barrier(const XcdBarrier& b) {
    asm volatile("s_waitcnt vmcnt(0)" ::: "memory");
    __syncthreads();
    if (threadIdx.x == 0) {
        unsigned* bar = b.bar;
        __builtin_amdgcn_s_waitcnt(0);
        unsigned nloc = b.st[0], nx = b.st[1];
        if (nloc == 0u) { xcd_barrier_complete(bar, b.x, nloc, nx); b.st[0] = nloc; b.st[1] = nx; }
        const unsigned old = xb_add(&bar[XB_XSUB(b.x)], 1u);
        const unsigned gen = old / nloc;
        if (old + 1u == (gen + 1u) * nloc) {
            __builtin_amdgcn_fence(__ATOMIC_RELEASE, "agent");
            asm volatile("s_waitcnt vmcnt(0)" ::: "memory");
            const unsigned og = xb_add(&bar[XB_TOP], 1u);
            const unsigned tg = og / nx;
            if (og + 1u == (tg + 1u) * nx) xb_add(&bar[XB_TOPGEN], 1u);
            else XB_SPIN(xb_ld(&bar[XB_TOPGEN]) == tg, bar);
            __builtin_amdgcn_fence(__ATOMIC_ACQUIRE, "agent");
            xb_add(&bar[XB_XGEN(b.x)], 1u);
            asm volatile("s_waitcnt vmcnt(0)" ::: "memory");
        } else {
            XB_SPIN(xb_ld(&bar[XB_XGEN(b.x)]) == gen, bar);
            __builtin_amdgcn_fence(__ATOMIC_ACQUIRE, "agent");
            asm volatile("s_waitcnt vmcnt(0)" ::: "memory");
        }
    }
    __syncthreads();
}

__device__ __forceinline__ float wave_sum(float v) {
#pragma unroll
    for (int o = 1; o < 64; o <<= 1) v += __shfl_xor(v, o);
    return v;
}
__device__ __forceinline__ float bf_lo(unsigned u) { return __uint_as_float(u << 16); }
__device__ __forceinline__ float bf_hi(unsigned u) { return __uint_as_float(u & 0xffff0000u); }
typedef _Float16 h16x2 __attribute__((ext_vector_type(2)));
__device__ __forceinline__ unsigned pk_f16(float a, float b) { h16x2 v; v[0] = (_Float16)a; v[1] = (_Float16)b; return __builtin_bit_cast(unsigned, v); }
__device__ __forceinline__ float f16_lo(unsigned u) { return (float)__builtin_bit_cast(h16x2, u)[0]; }
__device__ __forceinline__ float f16_hi(unsigned u) { return (float)__builtin_bit_cast(h16x2, u)[1]; }

__device__ __forceinline__ void h0_phase(const float* x, const float* ctx, const float* modl, bf16_t* HB, int gw, int NGW, int lane, int rstart = -1) {
    for (int r = rstart < 0 ? gw : rstart; r < MT; r += NGW) {
        const float* src = r < ML ? x + (size_t)r * D : ctx + (size_t)(r - ML) * D;
        const float* sh = modl + (size_t)vec_of_row(r) * NMODC; const float* sc = sh + D;
        bf16_t* o = HB + hb_off(r, 4 * lane);
#pragma unroll
        for (int j = 0; j < 8; ++j) {
            const f32x4 v = *((const f32x4*)src + lane + 64 * j), a = *((const f32x4*)sc + lane + 64 * j), b = *((const f32x4*)sh + lane + 64 * j);
            const f32x4 h = v * (a + 1.f) + b;
            u32x2 w; w.x = cvt_pk_bf16(h[0], h[1]); w.y = cvt_pk_bf16(h[2], h[3]); *(u32x2*)(o + (size_t)j * 4 * 16384) = w;
        }
    }
}
#define H0_LD1(dst, ptr, off) asm volatile("global_load_dwordx4 %0, %1, off offset:" #off : "=v"(dst) : "v"(ptr) : "memory")
#define H0_LOADSET(X, r) do { const float* xp_ = x + (size_t)(r) * D + 4 * lane; const float* xq_ = xp_ + 1024; \
        H0_LD1(X[0], xp_, 0); H0_LD1(X[1], xp_, 1024); H0_LD1(X[2], xp_, 2048); H0_LD1(X[3], xp_, 3072); H0_LD1(X[4], xq_, 0); H0_LD1(X[5], xq_, 1024); H0_LD1(X[6], xq_, 2048); H0_LD1(X[7], xq_, 3072); } while (0)
#define H0_WAIT(n) asm volatile("s_waitcnt vmcnt(" #n ")" ::: "memory")
#define H0_HALF(X, i_, AP, BP) do { \
        constexpr int i = (i_); const int r = gw + i * NGW; \
        if (i >= 2 && i + 1 < 8) H0_WAIT(24); else if (i == 1) H0_WAIT(16); else if (i == 0) H0_WAIT(8); else H0_WAIT(0); \
        asm volatile("" : "+v"(X[0]), "+v"(X[1]), "+v"(X[2]), "+v"(X[3]), "+v"(X[4]), "+v"(X[5]), "+v"(X[6]), "+v"(X[7]) :: "memory");        \
        u32x2 w[8]; \
        _Pragma("unroll") for (int j = 0; j < 8; ++j) { \
            asm volatile("" : "+v"(AP[j]), "+v"(BP[j]));           \
            const f32x4 v = __builtin_bit_cast(f32x4, X[j]); \
            const f32x4 a = (f32x4){f16_lo(AP[j].x), f16_hi(AP[j].x), f16_lo(AP[j].y), f16_hi(AP[j].y)}, b = (f32x4){f16_lo(BP[j].x), f16_hi(BP[j].x), f16_lo(BP[j].y), f16_hi(BP[j].y)}; \
            const f32x4 h = v * a + b; w[j].x = cvt_pk_bf16(h[0], h[1]); w[j].y = cvt_pk_bf16(h[2], h[3]); } \
        if (i + 2 < 8) H0_LOADSET(X, r + 2 * NGW);                 \
        bf16_t* o = HB + hb_off(r, 4 * lane); \
        _Pragma("unroll") for (int j = 0; j < 8; ++j) *(u32x2*)(o + (size_t)j * 4 * 16384) = w[j]; \
    } while (0)
__device__ __forceinline__ void h0b_phase(const float* x, const float* ctx, const float* modl, bf16_t* HB, int gw, int NGW, int lane) {
    u32x2 a0[8], b0[8], a1[8], b1[8];
#pragma unroll
    for (int j = 0; j < 8; ++j) {
        const float* sh0 = modl; const float* sh1 = modl + NMODC;
        const f32x4 s0 = *((const f32x4*)(sh0 + D) + lane + 64 * j) + 1.f, t0 = *((const f32x4*)sh0 + lane + 64 * j), s1 = *((const f32x4*)(sh1 + D) + lane + 64 * j) + 1.f, t1 = *((const f32x4*)sh1 + lane + 64 * j);
        a0[j].x = pk_f16(s0[0], s0[1]); a0[j].y = pk_f16(s0[2], s0[3]); b0[j].x = pk_f16(t0[0], t0[1]); b0[j].y = pk_f16(t0[2], t0[3]);
        a1[j].x = pk_f16(s1[0], s1[1]); a1[j].y = pk_f16(s1[2], s1[3]); b1[j].x = pk_f16(t1[0], t1[1]); b1[j].y = pk_f16(t1[2], t1[3]);
    }
#pragma unroll
    for (int j = 0; j < 8; ++j) asm volatile("" : "+v"(a0[j]), "+v"(b0[j]), "+v"(a1[j]), "+v"(b1[j]));
    asm volatile("s_waitcnt vmcnt(0)" ::: "memory");
    u32x4 xa[8], xb[8];
    H0_LOADSET(xa, gw); H0_LOADSET(xb, gw + NGW);
    H0_HALF(xa, 0, a0, b0); H0_HALF(xb, 1, a0, b0); H0_HALF(xa, 2, a0, b0); H0_HALF(xb, 3, a0, b0); H0_HALF(xa, 4, a1, b1); H0_HALF(xb, 5, a1, b1); H0_HALF(xa, 6, a1, b1); H0_HALF(xb, 7, a1, b1);
    h0_phase(x, ctx, modl, HB, gw, NGW, lane, gw + 8 * NGW);
}
#undef H0_LD1
#undef H0_LOADSET
#undef H0_WAIT
#undef H0_HALF
template <bool XF32, bool OUTF32, bool HPERM = false>
__device__ __forceinline__ void ln2_phase(const void* xsrc, const bf16_t* YB, void* xdst, bf16_t* HB, const float* lng, const float* lnb, const float* modn, int ish, int gw, int NGW, int lane) {
    const int half = NGW >> 1, b = gw >= half ? 1 : 0, gwl = gw - b * half;
    f32x4 g[4][2], bb[4][2], ha[4][2], hb[4][2];
#pragma unroll
    for (int j = 0; j < 4; ++j)
#pragma unroll
        for (int e = 0; e < 2; ++e) {
            const int c = 8 * lane + 512 * j + 4 * e;
            g[j][e] = *(const f32x4*)(lng + c); bb[j][e] = *(const f32x4*)(lnb + c);
            if (HB) { const float* sh = modn + (size_t)b * NMODC + (size_t)ish * D; const f32x4 s1 = *(const f32x4*)(sh + D + c) + 1.f, s0 = *(const f32x4*)(sh + c);
                ha[j][e] = g[j][e] * s1; hb[j][e] = bb[j][e] * s1 + s0; }
            else { ha[j][e] = g[j][e]; hb[j][e] = bb[j][e]; }
        }
    const int r0 = b * SEQ + gwl, rend = (b + 1) * SEQ;
    f32x4 xf[4][2]; u32x4 xr[4], yr[4];
#define LN2_LOAD(r) do { _Pragma("unroll") for (int j = 0; j < 4; ++j) { \
        if (XF32) { xf[j][0] = *(const f32x4*)((const float*)xsrc + (size_t)(r) * D + 8 * lane + 512 * j); xf[j][1] = *(const f32x4*)((const float*)xsrc + (size_t)(r) * D + 8 * lane + 512 * j + 4); } \
        else xr[j] = *(const u32x4*)((const bf16_t*)xsrc + (size_t)(r) * D + 8 * lane + 512 * j); \
        yr[j] = *(const u32x4*)(YB + (size_t)(r) * D + 8 * lane + 512 * j); } } while (0)
    if (!XF32 && r0 < rend) LN2_LOAD(r0);
    for (int r = r0; r < rend; r += half) {
        if (XF32) LN2_LOAD(r);
        f32x4 z[4][2]; float s = 0.f;
#pragma unroll
        for (int j = 0; j < 4; ++j) {
            f32x4 x0, x1;
            if (XF32) { x0 = xf[j][0]; x1 = xf[j][1]; }
            else { x0 = (f32x4){f16_lo(xr[j][0]), f16_hi(xr[j][0]), f16_lo(xr[j][1]), f16_hi(xr[j][1])}; x1 = (f32x4){f16_lo(xr[j][2]), f16_hi(xr[j][2]), f16_lo(xr[j][3]), f16_hi(xr[j][3])}; }
            const f32x4 y0 = (f32x4){bf_lo(yr[j][0]), bf_hi(yr[j][0]), bf_lo(yr[j][1]), bf_hi(yr[j][1])}, y1 = (f32x4){bf_lo(yr[j][2]), bf_hi(yr[j][2]), bf_lo(yr[j][3]), bf_hi(yr[j][3])};
            z[j][0] = x0 * ALPHA + y0; z[j][1] = x1 * ALPHA + y1;
            s += ((z[j][0][0] + z[j][0][1]) + (z[j][0][2] + z[j][0][3])) + ((z[j][1][0] + z[j][1][1]) + (z[j][1][2] + z[j][1][3]));
        }
        if (!XF32 && r + half < rend) LN2_LOAD(r + half);
        const float mean = wave_sum(s) * (1.f / D); float q = 0.f;
#pragma unroll
        for (int j = 0; j < 4; ++j)
#pragma unroll
            for (int e = 0; e < 2; ++e) { z[j][e] = z[j][e] - mean; q += (z[j][e][0] * z[j][e][0] + z[j][e][1] * z[j][e][1]) + (z[j][e][2] * z[j][e][2] + z[j][e][3] * z[j][e][3]); }
        const float rstd = 1.f / sqrtf(wave_sum(q) * (1.f / D) + LN_EPS);
#pragma unroll
        for (int j = 0; j < 4; ++j) {
            const f32x4 n0 = z[j][0] * rstd, n1 = z[j][1] * rstd;
            const f32x4 o0 = n0 * g[j][0] + bb[j][0], o1 = n1 * g[j][1] + bb[j][1];
            if (OUTF32) { float* op = (float*)xdst + (size_t)r * D + 8 * lane + 512 * j; *(f32x4*)op = o0; *(f32x4*)(op + 4) = o1; }
            else { u32x4 w; w.x = pk_f16(o0[0], o0[1]); w.y = pk_f16(o0[2], o0[3]); w.z = pk_f16(o1[0], o1[1]); w.w = pk_f16(o1[2], o1[3]); *(u32x4*)((bf16_t*)xdst + (size_t)r * D + 8 * lane + 512 * j) = w; }
            if (HB) { const f32x4 h0 = n0 * ha[j][0] + hb[j][0], h1 = n1 * ha[j][1] + hb[j][1];
                u32x4 w; w.x = cvt_pk_bf16(h0[0], h0[1]); w.y = cvt_pk_bf16(h0[2], h0[3]); w.z = cvt_pk_bf16(h1[0], h1[1]); w.w = cvt_pk_bf16(h1[2], h1[3]); const int rh = HPERM ? ((r & ~255) | slot_of_tok(r & 255)) : r; *(u32x4*)(HB + hb_off(rh, 8 * lane + 512 * j)) = w; }
        }
    }
#undef LN2_LOAD
}
#define LN3_LD1(dst, ptr, off) asm volatile("global_load_dwordx4 %0, %1, off offset:" #off : "=v"(dst) : "v"(ptr) : "memory")
#define LN3_LOADSET(X, Y, r) do { const bf16_t* yp_ = YB + (size_t)(r) * D + 8 * lane; \
        if constexpr (XF32) { const float* xp_ = (const float*)xsrc + (size_t)(r) * D + 8 * lane; const float* xq_ = xp_ + 1024;        \
            LN3_LD1(X[0], xp_, 0); LN3_LD1(X[1], xp_, 16); LN3_LD1(Y[0], yp_, 0); LN3_LD1(X[2], xp_, 2048); LN3_LD1(X[3], xp_, 2064); LN3_LD1(Y[1], yp_, 1024); \
            LN3_LD1(X[4], xq_, 0); LN3_LD1(X[5], xq_, 16); LN3_LD1(Y[2], yp_, 2048); LN3_LD1(X[6], xq_, 2048); LN3_LD1(X[7], xq_, 2064); LN3_LD1(Y[3], yp_, 3072); } \
        else { const bf16_t* xp_ = (const bf16_t*)xsrc + (size_t)(r) * D + 8 * lane; \
            LN3_LD1(X[0], xp_, 0); LN3_LD1(Y[0], yp_, 0); LN3_LD1(X[1], xp_, 1024); LN3_LD1(Y[1], yp_, 1024); LN3_LD1(X[2], xp_, 2048); LN3_LD1(Y[2], yp_, 2048); LN3_LD1(X[3], xp_, 3072); LN3_LD1(Y[3], yp_, 3072); } } while (0)
#define LN3_WAIT(n) asm volatile("s_waitcnt vmcnt(" #n ")" ::: "memory")
#define LN3_PIN(X, Y) do { if constexpr (XF32) asm volatile("" : "+v"(X[0]), "+v"(X[1]), "+v"(X[2]), "+v"(X[3]), "+v"(X[4]), "+v"(X[5]), "+v"(X[6]), "+v"(X[7]), "+v"(Y[0]), "+v"(Y[1]), "+v"(Y[2]), "+v"(Y[3]) :: "memory"); \
        else asm volatile("" : "+v"(X[0]), "+v"(X[1]), "+v"(X[2]), "+v"(X[3]), "+v"(Y[0]), "+v"(Y[1]), "+v"(Y[2]), "+v"(Y[3]) :: "memory"); } while (0)
#define LN3_HALF(X, Y, i_) do { \
        const int i = (i_), r = r0 + i * half; \
        if (i >= 2 && i + 1 < n) { if constexpr (XF32) LN3_WAIT(28); else LN3_WAIT(24); } else if (i == 1) { if constexpr (XF32) LN3_WAIT(20); else LN3_WAIT(16); } \
        else if (i == 0) { if constexpr (XF32) LN3_WAIT(12); else LN3_WAIT(8); } else LN3_WAIT(0);        \
        LN3_PIN(X, Y);                                             \
        f32x4 z[4][2]; float s = 0.f; \
        _Pragma("unroll") for (int j = 0; j < 4; ++j) { \
            f32x4 x0, x1; \
            if constexpr (XF32) { x0 = __builtin_bit_cast(f32x4, X[2 * j]); x1 = __builtin_bit_cast(f32x4, X[2 * j + 1]); } \
            else { x0 = (f32x4){f16_lo(X[j][0]), f16_hi(X[j][0]), f16_lo(X[j][1]), f16_hi(X[j][1])}; x1 = (f32x4){f16_lo(X[j][2]), f16_hi(X[j][2]), f16_lo(X[j][3]), f16_hi(X[j][3])}; } \
            const f32x4 y0 = (f32x4){bf_lo(Y[j][0]), bf_hi(Y[j][0]), bf_lo(Y[j][1]), bf_hi(Y[j][1])}, y1 = (f32x4){bf_lo(Y[j][2]), bf_hi(Y[j][2]), bf_lo(Y[j][3]), bf_hi(Y[j][3])}; \
            z[j][0] = x0 * ALPHA + y0; z[j][1] = x1 * ALPHA + y1; \
            s += ((z[j][0][0] + z[j][0][1]) + (z[j][0][2] + z[j][0][3])) + ((z[j][1][0] + z[j][1][1]) + (z[j][1][2] + z[j][1][3])); } \
        if (i + 2 < n) LN3_LOADSET(X, Y, r + 2 * half);            \
        const float mean = wave_sum(s) * (1.f / D); float q = 0.f; \
        _Pragma("unroll") for (int j = 0; j < 4; ++j) _Pragma("unroll") for (int e = 0; e < 2; ++e) { z[j][e] = z[j][e] - mean; q += (z[j][e][0] * z[j][e][0] + z[j][e][1] * z[j][e][1]) + (z[j][e][2] * z[j][e][2] + z[j][e][3] * z[j][e][3]); } \
        const float rstd = 1.f / sqrtf(wave_sum(q) * (1.f / D) + LN_EPS); \
        _Pragma("unroll") for (int j = 0; j < 4; ++j) { \
            const f32x4 n0 = z[j][0] * rstd, n1 = z[j][1] * rstd; \
            f32x4 g0, g1, b0, b1; \
            if constexpr (OUTF32) { g0 = gf[j][0]; g1 = gf[j][1]; b0 = bf[j][0]; b1 = bf[j][1]; } \
            else { asm volatile("" : "+v"(gp[j]), "+v"(bp[j]), "+v"(hap[j]), "+v"(hbp[j]));        \
                g0 = (f32x4){f16_lo(gp[j][0]), f16_hi(gp[j][0]), f16_lo(gp[j][1]), f16_hi(gp[j][1])}; g1 = (f32x4){f16_lo(gp[j][2]), f16_hi(gp[j][2]), f16_lo(gp[j][3]), f16_hi(gp[j][3])}; \
                b0 = (f32x4){f16_lo(bp[j][0]), f16_hi(bp[j][0]), f16_lo(bp[j][1]), f16_hi(bp[j][1])}; b1 = (f32x4){f16_lo(bp[j][2]), f16_hi(bp[j][2]), f16_lo(bp[j][3]), f16_hi(bp[j][3])}; } \
            const f32x4 o0 = n0 * g0 + b0, o1 = n1 * g1 + b1; \
            if constexpr (OUTF32) { float* op = (float*)xdst + (size_t)r * D + 8 * lane + 512 * j; *(f32x4*)op = o0; *(f32x4*)(op + 4) = o1; }        \
            else { \
            { u32x4 w; w.x = pk_f16(o0[0], o0[1]); w.y = pk_f16(o0[2], o0[3]); w.z = pk_f16(o1[0], o1[1]); w.w = pk_f16(o1[2], o1[3]); *(u32x4*)((bf16_t*)xdst + (size_t)r * D + 8 * lane + 512 * j) = w; } \
            { const f32x4 a0 = (f32x4){f16_lo(hap[j][0]), f16_hi(hap[j][0]), f16_lo(hap[j][1]), f16_hi(hap[j][1])}, a1 = (f32x4){f16_lo(hap[j][2]), f16_hi(hap[j][2]), f16_lo(hap[j][3]), f16_hi(hap[j][3])}; \
              const f32x4 c0 = (f32x4){f16_lo(hbp[j][0]), f16_hi(hbp[j][0]), f16_lo(hbp[j][1]), f16_hi(hbp[j][1])}, c1 = (f32x4){f16_lo(hbp[j][2]), f16_hi(hbp[j][2]), f16_lo(hbp[j][3]), f16_hi(hbp[j][3])}; \
              const f32x4 h0 = n0 * a0 + c0, h1 = n1 * a1 + c1; \
              u32x4 w; w.x = cvt_pk_bf16(h0[0], h0[1]); w.y = cvt_pk_bf16(h0[2], h0[3]); w.z = cvt_pk_bf16(h1[0], h1[1]); w.w = cvt_pk_bf16(h1[2], h1[3]); *(u32x4*)(HB + hb_off(r, 8 * lane + 512 * j)) = w; } } } \
    } while (0)
template <bool XF32, bool OUTF32>
__device__ __forceinline__ void ln3_phase(const void* xsrc, const bf16_t* YB, void* xdst, bf16_t* HB, const float* lng, const float* lnb, const float* modn, int ish, int gw, int NGW, int lane) {
    const int half = NGW >> 1, b = gw >= half ? 1 : 0, gwl = gw - b * half;
    u32x4 gp[4], bp[4], hap[4], hbp[4]; f32x4 gf[4][2], bf[4][2];
#pragma unroll
    for (int j = 0; j < 4; ++j) {
        f32x4 gv[2], bv[2], hav[2], hbv[2];
#pragma unroll
        for (int e = 0; e < 2; ++e) {
            const int c = 8 * lane + 512 * j + 4 * e;
            gv[e] = *(const f32x4*)(lng + c); bv[e] = *(const f32x4*)(lnb + c);
            if constexpr (OUTF32) { gf[j][e] = gv[e]; bf[j][e] = bv[e]; hav[e] = gv[e]; hbv[e] = bv[e]; continue; }
            const float* sh = modn + (size_t)b * NMODC + (size_t)ish * D; const f32x4 s1 = *(const f32x4*)(sh + D + c) + 1.f, s0 = *(const f32x4*)(sh + c);
            hav[e] = gv[e] * s1; hbv[e] = bv[e] * s1 + s0;
        }
        gp[j].x = pk_f16(gv[0][0], gv[0][1]); gp[j].y = pk_f16(gv[0][2], gv[0][3]); gp[j].z = pk_f16(gv[1][0], gv[1][1]); gp[j].w = pk_f16(gv[1][2], gv[1][3]);
        bp[j].x = pk_f16(bv[0][0], bv[0][1]); bp[j].y = pk_f16(bv[0][2], bv[0][3]); bp[j].z = pk_f16(bv[1][0], bv[1][1]); bp[j].w = pk_f16(bv[1][2], bv[1][3]);
        hap[j].x = pk_f16(hav[0][0], hav[0][1]); hap[j].y = pk_f16(hav[0][2], hav[0][3]); hap[j].z = pk_f16(hav[1][0], hav[1][1]); hap[j].w = pk_f16(hav[1][2], hav[1][3]);
        hbp[j].x = pk_f16(hbv[0][0], hbv[0][1]); hbp[j].y = pk_f16(hbv[0][2], hbv[0][3]); hbp[j].z = pk_f16(hbv[1][0], hbv[1][1]); hbp[j].w = pk_f16(hbv[1][2], hbv[1][3]);
    }
    const int r0 = b * SEQ + gwl;
#pragma unroll
    for (int j = 0; j < 4; ++j) { if constexpr (OUTF32) asm volatile("" : "+v"(gf[j][0]), "+v"(gf[j][1]), "+v"(bf[j][0]), "+v"(bf[j][1])); else asm volatile("" : "+v"(gp[j]), "+v"(bp[j]), "+v"(hap[j]), "+v"(hbp[j])); }
    asm volatile("s_waitcnt vmcnt(0)" ::: "memory");
    u32x4 xa[XF32 ? 8 : 4], ya[4], xb[XF32 ? 8 : 4], yb[4];
    LN3_LOADSET(xa, ya, r0);
    LN3_LOADSET(xb, yb, r0 + half);
    constexpr int n = 8;
    LN3_HALF(xa, ya, 0); LN3_HALF(xb, yb, 1); LN3_HALF(xa, ya, 2); LN3_HALF(xb, yb, 3); LN3_HALF(xa, ya, 4); LN3_HALF(xb, yb, 5); LN3_HALF(xa, ya, 6); LN3_HALF(xb, yb, 7);
}
#undef LN3_LOADSET
#undef LN3_LD1
#undef LN3_WAIT
#undef LN3_PIN
#undef LN3_HALF
__device__ __forceinline__ void ln_ctx_phase(const float* srcC, const bf16_t* slab, int nparts, float* Xc, bf16_t* HBc, const float* lng, const float* lnb, const float* modn, int ish,
                                             LAS float* red, int bid, int G, int tid, int lane, int wave) {
    const f32x4 gv = *(const f32x4*)(lng + 4 * tid), bv = *(const f32x4*)(lnb + 4 * tid);
    const float* sh = modn + (size_t)2 * NMODC + (size_t)ish * D; const float* sc = sh + D;
    const f32x4 s1 = *(const f32x4*)(sc + 4 * tid) + 1.f, s0 = *(const f32x4*)(sh + 4 * tid);
    for (int rr = bid; rr < MC; rr += 2 * G) {
        const int r2 = rr + G; const bool two = r2 < MC; const int rb = two ? r2 : rr;
        f32x4 za = *(const f32x4*)(srcC + (size_t)rr * D + 4 * tid) * ALPHA, zb = *(const f32x4*)(srcC + (size_t)rb * D + 4 * tid) * ALPHA;
        for (int s = 0; s < nparts; ++s) {
            const u32x2 pa = *(const u32x2*)(slab + ((size_t)s * MC + rr) * D + 4 * tid), pb = *(const u32x2*)(slab + ((size_t)s * MC + rb) * D + 4 * tid);
            za += (f32x4){bf_lo(pa.x), bf_hi(pa.x), bf_lo(pa.y), bf_hi(pa.y)}; zb += (f32x4){bf_lo(pb.x), bf_hi(pb.x), bf_lo(pb.y), bf_hi(pb.y)};
        }
        const float sa = wave_sum((za[0] + za[1]) + (za[2] + za[3])), sb = wave_sum((zb[0] + zb[1]) + (zb[2] + zb[3]));
        __syncthreads();
        if (lane == 0) { red[wave] = sa; red[8 + wave] = sb; }
        __syncthreads();
        float ta = 0.f, tb = 0.f;
#pragma unroll
        for (int w = 0; w < 8; ++w) { ta += red[w]; tb += red[8 + w]; }
        za = za - ta * (1.f / D); zb = zb - tb * (1.f / D);
        const float qa = wave_sum((za[0] * za[0] + za[1] * za[1]) + (za[2] * za[2] + za[3] * za[3])), qb = wave_sum((zb[0] * zb[0] + zb[1] * zb[1]) + (zb[2] * zb[2] + zb[3] * zb[3]));
        __syncthreads();
        if (lane == 0) { red[wave] = qa; red[8 + wave] = qb; }
        __syncthreads();
        float ua = 0.f, ub = 0.f;
#pragma unroll
        for (int w = 0; w < 8; ++w) { ua += red[w]; ub += red[8 + w]; }
        const float ra = 1.f / sqrtf(ua * (1.f / D) + LN_EPS), rbs = 1.f / sqrtf(ub * (1.f / D) + LN_EPS);
        const f32x4 xa = za * ra * gv + bv, xb = zb * rbs * gv + bv;
        *(f32x4*)(Xc + (size_t)rr * D + 4 * tid) = xa; *(f32x4*)(Xc + (size_t)rb * D + 4 * tid) = xb;
        const f32x4 ha = xa * s1 + s0, hb2 = xb * s1 + s0;
        u32x2 wa, wb; wa.x = cvt_pk_bf16(ha[0], ha[1]); wa.y = cvt_pk_bf16(ha[2], ha[3]); wb.x = cvt_pk_bf16(hb2[0], hb2[1]); wb.y = cvt_pk_bf16(hb2[2], hb2[3]);
        *(u32x2*)(HBc + hb_off(ML + rr, 4 * tid)) = wa; *(u32x2*)(HBc + hb_off(ML + rb, 4 * tid)) = wb;
    }
    __syncthreads();
}
__device__ __forceinline__ void conv_phase(const bf16_t* GB, const bf16_t* VB, const float* wconv, bf16_t* A2, int gw, int NGW, int lane) {
    f32x4 w[3][4];
#pragma unroll
    for (int k = 0; k < 3; ++k)
#pragma unroll
        for (int q = 0; q < 4; ++q) w[k][q] = *((const f32x4*)(wconv + k * 1024 + 16 * lane) + q);
    for (int r = gw; r < MT; r += NGW) {
        int pos, L; if (r < ML) { pos = r & (SEQ - 1); L = SEQ; } else { pos = (r - ML) & (CTXL - 1); L = CTXL; }
        const u32x4 z4 = (u32x4){0u, 0u, 0u, 0u};
        const u32x4* vc = (const u32x4*)(VB + (size_t)r * 1024 + 16 * lane);
        const u32x4* gp = (const u32x4*)(GB + (size_t)r * 1024 + 16 * lane);
        u32x4 o[2];
#pragma unroll
        for (int h = 0; h < 2; ++h) {
            const u32x4 c = vc[h], p = pos > 0 ? vc[h - 128] : z4, n = pos < L - 1 ? vc[h + 128] : z4, g = gp[h];
            u32x4 ov;
#pragma unroll
            for (int e = 0; e < 4; ++e) {
                const f32x4 w0 = w[0][2 * h + (e >> 1)], w1 = w[1][2 * h + (e >> 1)], w2 = w[2][2 * h + (e >> 1)];
                const int i0 = (e & 1) * 2;
                const float lo = bf_lo(g[e]) * (w0[i0] * bf_lo(p[e]) + w1[i0] * bf_lo(c[e]) + w2[i0] * bf_lo(n[e]));
                const float hi = bf_hi(g[e]) * (w0[i0 + 1] * bf_hi(p[e]) + w1[i0 + 1] * bf_hi(c[e]) + w2[i0 + 1] * bf_hi(n[e]));
                ov[e] = cvt_pk_bf16(lo, hi);
            }
            o[h] = ov;
        }
        u32x4* op = (u32x4*)(A2 + hb_off(r, 16 * lane)); op[0] = o[0]; op[1] = o[1];
    }
}

struct Params {
    const float *x, *c, *ctx, *c_ctx, *w_mod, *b_mod, *ln_g, *ln_b, *wg, *wu, *wd, *ab_in, *ab_conv, *ab_out, *at_in, *at_sink, *at_out;
    float* out; unsigned char* ws; int ph_lo, ph_hi;
};
__device__ __forceinline__ int swz128(int j, int half) { return 256 * (j >> 7) + 128 * half + (j & 127); }

constexpr int CP_NFFN = 12 * 5632, CP_NITEMS = CP_NFFN + 4 * 1024 + 2048 + 2560 + 2048;
constexpr int CP_MAT = 5632, CP_OTH0 = CP_NFFN, CP_OTH1 = CP_NFFN + 6144;
struct TrDesc { const float* W; bf16_t* WT; int K, ldn, c0, drow0, kb; bool blk; bool perm; };
__device__ __forceinline__ TrDesc copy_desc(const Params& P, int it) {
    unsigned char* ws = P.ws; TrDesc d; d.perm = true;
    if (it < CP_NFFN) {
        const int mi = it / 5632, r = it % 5632, idx = mi / 3, ty = mi % 3;
        if (ty < 2) { const int nb = r % 176; d.kb = r / 176; d.W = (ty == 0 ? P.wg : P.wu) + (size_t)idx * D * FF; d.K = D; d.ldn = FF; d.c0 = 32 * nb;
            d.WT = (bf16_t*)(ws + WS_W1I + (size_t)idx * W1I_BYTES); d.drow0 = swz128(32 * nb, ty); d.blk = true; }
        else { const int nb = r % 64; d.kb = r / 64; d.W = P.wd + (size_t)idx * FF * D; d.K = FF; d.ldn = D; d.c0 = 32 * nb; d.WT = (bf16_t*)(ws + WS_W2T + (size_t)idx * W2T_BYTES); d.drow0 = 32 * nb; d.blk = true; }
        return d;
    }
    int r = it - CP_NFFN; d.K = D; d.blk = true;
    if (r < 4096) { const int seg = r >> 10, q = r & 1023, nb = q & 31; d.kb = q >> 5; d.W = P.ab_in; d.ldn = 4096; d.c0 = seg * 1024 + 32 * nb; d.WT = (bf16_t*)(ws + WS_WMI);
        d.drow0 = seg == 0 ? 32 * nb : (seg == 3 ? 3072 + 32 * nb : 1024 + swz128(32 * nb, seg - 1)); return d; }
    r -= 4096;
    if (r < 2048) { const int nb = r & 63; d.kb = r >> 6; d.W = P.ab_out; d.ldn = D; d.c0 = 32 * nb; d.WT = (bf16_t*)(ws + WS_WMO); d.drow0 = 32 * nb; return d; }
    r -= 2048;
    if (r < 2560) { const int nb = r % 80; d.kb = r / 80; d.W = P.at_in; d.ldn = 2560; d.perm = false; d.c0 = 32 * nb; d.WT = (bf16_t*)(ws + WS_WQKV); d.drow0 = 32 * nb; return d; }
    r -= 2560;
    { const int nb = r & 63; d.kb = r >> 6; d.W = P.at_out; d.ldn = D; d.c0 = 32 * nb; d.WT = (bf16_t*)(ws + WS_WO); d.drow0 = 32 * nb; return d; }
}
__device__ __forceinline__ void tr_load(const TrDesc& d, f32x4 (&v)[8], int lane) {
    const float* src = d.W + (size_t)(64 * d.kb + (lane >> 3)) * d.ldn + d.c0 + 4 * (lane & 7);
#pragma unroll
    for (int i = 0; i < 8; ++i) v[i] = __builtin_nontemporal_load((const f32x4*)(src + (size_t)(8 * i) * d.ldn));
}
__device__ __forceinline__ void tr_store(const TrDesc& d, const f32x4 (&v)[8], LAS float* scr, int lane) {
#pragma unroll
    for (int i = 0; i < 8; ++i) { LAS float* p = scr + (8 * i + (lane >> 3)) * 33 + 4 * (lane & 7); p[0] = v[i][0]; p[1] = v[i][1]; p[2] = v[i][2]; p[3] = v[i][3]; }
    LDS_WAIT(); asm volatile("" ::: "memory");
    const int c = lane & 7;
#pragma unroll
    for (int j = 0; j < 4; ++j) { const int n = (lane >> 3) + 8 * j; const LAS float* s = scr + (8 * c) * 33 + n;
        u32x4 o; o.x = cvt_pk_bf16(s[0 * 33], s[1 * 33]); o.y = cvt_pk_bf16(s[2 * 33], s[3 * 33]); o.z = cvt_pk_bf16(s[4 * 33], s[5 * 33]); o.w = cvt_pk_bf16(s[6 * 33], s[7 * 33]);
        const int dr = d.drow0 + n;
        if (d.blk) { int R = dr & 127; if (d.perm) { const int v = R & 31; R = (R & ~31) + 16 * ((v >> 2) & 1) + 4 * (v >> 3) + (v & 3); }
            *(u32x4*)(d.WT + (size_t)(dr >> 8) * 256 * d.K + (size_t)d.kb * 16384 + ((dr >> 7) & 1) * 8192 + (lds_img_byte(R, 8 * c) >> 1)) = o; }
        else *(u32x4*)(d.WT + (size_t)dr * d.K + 64 * d.kb + 8 * c) = o; }
    LDS_WAIT(); asm volatile("" ::: "memory");
}
__device__ __forceinline__ void copy_range(const Params& P, LAS float* scr, int lo, int hi, int slot, int nslots, int lane) {
    for (int it = lo + slot; it < hi; it += nslots) { const TrDesc d = copy_desc(P, it); f32x4 v[8]; tr_load(d, v, lane); tr_store(d, v, scr, lane); }
}
template <int PARTS = 15>
__device__ __forceinline__ void p0_prologue(const Params& P, LAS unsigned char* lds, int tid, int lane, int wave, int bid, int G) {
    unsigned char* ws = P.ws;
    if (PARTS & 1) {
        LAS float* sl = (LAS float*)lds;
        LAS float* red = (LAS float*)(lds + 24576);
        bool have = false;
        for (int it = bid; it < 256; it += G) {
            if (!have) {
                for (int i = tid; i < 3 * D; i += 512) { const int v = i >> 11, k = i & (D - 1); const float xv = v < 2 ? P.c[v * D + k] : P.c_ctx[k]; sl[i] = xv / (1.f + expf(-xv)); }
                have = true;
            }
            __syncthreads();
            const int l = it >> 7, j0 = (it & 127) * 144, q = tid % 36, kl = tid / 36;
            if (tid < 504) {
                const float* wp = P.w_mod + (size_t)l * D * NMODC + j0 + 4 * q;
                f32x4 a0 = {0.f, 0.f, 0.f, 0.f}, a1 = a0, a2 = a0;
#pragma unroll 8
                for (int k = kl; k < D; k += 14) { const f32x4 w = __builtin_nontemporal_load((const f32x4*)(wp + (size_t)k * NMODC)); a0 += w * sl[k]; a1 += w * sl[D + k]; a2 += w * sl[2 * D + k]; }
                *(LAS f32x4*)(red + (kl * 3 + 0) * 144 + 4 * q) = a0; *(LAS f32x4*)(red + (kl * 3 + 1) * 144 + 4 * q) = a1; *(LAS f32x4*)(red + (kl * 3 + 2) * 144 + 4 * q) = a2;
            }
            __syncthreads();
            if (tid < 432) { const int v = tid / 144, col = tid % 144; float s = 0.f;
#pragma unroll
                for (int k2 = 0; k2 < 14; ++k2) s += red[(k2 * 3 + v) * 144 + col];
                ((float*)(ws + WS_MOD))[((size_t)l * 3 + v) * NMODC + j0 + col] = s + P.b_mod[(size_t)l * NMODC + j0 + col]; }
        }
        __syncthreads();
    }
    if (PARTS & 4) { LAS float* scr = (LAS float*)(lds + wave * 16384); copy_range(P, scr, 0, 2 * CP_MAT, bid * 8 + wave, G * 8, lane); copy_range(P, scr, 10 * CP_MAT, 11 * CP_MAT, bid * 8 + wave, G * 8, lane); }
    if (PARTS & 8) {
        const long gt = (long)bid * 512 + tid, NT = (long)G * 512;
        bf16_t* A1 = (bf16_t*)(ws + WS_A1);
        for (long it = gt; it < 256 * 256; it += NT) {
            const int row = (int)it >> 8, cc = (int)it & 255, part = row >> 7, k2 = row & 127, s = cc >> 7, n2 = cc & 127;
            float sn, cs; sincospif((float)((k2 * n2) & 127) * (1.f / 64.f), &sn, &cs);
            const float v = part == 0 ? (s == 0 ? cs : -sn) : (s == 0 ? -sn : -cs);
            A1[it] = (bf16_t)(cvt_pk_bf16(v, 0.f) & 0xffffu);
        }
        bf16_t* CHm = (bf16_t*)(ws + WS_CH);
        for (long it = gt; it < 512 * 32; it += NT) {
            const int row = (int)it >> 5, c0 = ((int)it & 31) * 8, gl = row >> 8, m = (row & 255) >> 1, s = row & 1, glc = c0 >> 7, cb = c0 & 127;
            if (gl != glc) { *(u32x4*)(CHm + (size_t)row * 1024 + c0) = (u32x4){0u, 0u, 0u, 0u}; continue; }
            float v[8];
#pragma unroll
            for (int e = 0; e < 8; ++e) { float sn, cs; sincospif((float)((m * (cb + e)) & 127) * (1.f / 64.f), &sn, &cs); v[e] = s == 0 ? cs : sn; }
            u32x4 o; o.x = cvt_pk_bf16(v[0], v[1]); o.y = cvt_pk_bf16(v[2], v[3]); o.z = cvt_pk_bf16(v[4], v[5]); o.w = cvt_pk_bf16(v[6], v[7]);
            *(u32x4*)(CHm + (size_t)row * 1024 + c0) = o;
        }
        bf16_t* A2M = (bf16_t*)(ws + WS_A2M);
        for (long it = gt; it < 32 * 256 * 64; it += NT) {
            const int kg = (int)(it >> 14), row = ((int)it >> 6) & 255, c0 = ((int)it & 63) * 8, k2l = row >> 6, k1 = row & 63, k2c = c0 >> 7, part = (c0 >> 6) & 1, n10 = c0 & 63;
            const int k = 4 * kg + k2l + 128 * k1;
            if (k2l != k2c) { *(u32x4*)(A2M + it * 8) = (u32x4){0u, 0u, 0u, 0u}; continue; }
            float v[8];
#pragma unroll
            for (int e = 0; e < 8; ++e) { float sn, cs; sincospif((float)((k * (n10 + e)) & 8191) * (1.f / 4096.f), &sn, &cs); v[e] = part == 0 ? cs : sn; }
            u32x4 o; o.x = cvt_pk_bf16(v[0], v[1]); o.y = cvt_pk_bf16(v[2], v[3]); o.z = cvt_pk_bf16(v[4], v[5]); o.w = cvt_pk_bf16(v[6], v[7]);
            *(u32x4*)(A2M + it * 8) = o;
        }
        bf16_t* AC = (bf16_t*)(ws + WS_ACTX);
        for (long it = gt; it < 256 * 64; it += NT) {
            const int k = (int)(it >> 6), n0 = ((int)it & 63) * 8; const bool sn = n0 >= 256; const int nb = n0 & 255;
            float v[8];
#pragma unroll
            for (int e = 0; e < 8; ++e) { const int idx = (k * (nb + e)) & 255; float s, c; sincospif((float)idx * (1.f / 128.f), &s, &c); v[e] = sn ? -s : c; }
            u32x4 o; o.x = cvt_pk_bf16(v[0], v[1]); o.y = cvt_pk_bf16(v[2], v[3]); o.z = cvt_pk_bf16(v[4], v[5]); o.w = cvt_pk_bf16(v[6], v[7]);
            *(u32x4*)(AC + (size_t)k * 512 + n0) = o;
        }
        float* rp = (float*)(ws + WS_ROPE);
        for (long it = gt; it < 128 * 16; it += NT) { const int p = (int)it >> 4, f = (int)it & 15; const float ang = (float)p * powf(10000.f, -(float)f / 16.f); rp[it] = cosf(ang); rp[2048 + it] = sinf(ang); }
    }
}

__device__ __forceinline__ int crow(int r, int hi) { return (r & 3) + 8 * (r >> 2) + 4 * hi; }
template <int ATT_MODE = 0>
__device__ __forceinline__ void attn_phase(LAS unsigned char* lds, const bf16_t* Q, const bf16_t* KB, const bf16_t* VT, const float* sink, bf16_t* O, int bid, int G, int tid, bool nostore = false) {
    const int lane = tid & 63, wid = __builtin_amdgcn_readfirstlane(tid >> 6), r32 = lane & 31, hi = lane >> 5;
    constexpr int SLOTB = 32768, VOFF = 16384;
    const int kl_off = (lane >> 3) * 256 + (((lane & 7) ^ ((lane >> 3) & 7)) * 8);
    const int vd0 = 4 * wid + (lane >> 4);
    const int vl_off = ((lane & 15) ^ (vd0 & 15)) * 8;
#define ATT_STAGE(unit_, ch_, slot_) do { \
        const int g_ = (unit_) & 3, blk_ = ((unit_) >> 2) & 63, b_ = (unit_) >> 8; \
        const long tok0_ = (ch_) < 2 ? (long)ML + b_ * CTXL + 128 * (ch_) : (long)b_ * SEQ + (blk_ + (ch_) - 3) * 128; \
        _Pragma("unroll") for (int i_ = 0; i_ < 2; ++i_) { \
            __builtin_amdgcn_global_load_lds((const unsigned*)(KB + (tok0_ + 8 * (wid + 8 * i_)) * 256 + g_ * 64 + kl_off), (LAS unsigned*)(lds + (slot_) * SLOTB + (wid + 8 * i_) * 1024), 16, 0, 0); \
            __builtin_amdgcn_global_load_lds((const unsigned*)(VT + (size_t)(g_ * 64 + vd0 + 32 * i_) * MT + tok0_ + vl_off), (LAS unsigned*)(lds + (slot_) * SLOTB + VOFF + (wid + 8 * i_) * 1024), 16, 0, 0); } } while (0)
    constexpr int QOFF = 2 * SLOTB;
    const int ql_off = (lane >> 3) * D + (((lane & 7) ^ ((lane >> 3) & 7)) * 8);
#define ATT_STAGE_Q(unit_, pass_) do { \
        const int g_ = (unit_) & 3, blk_ = ((unit_) >> 2) & 63, b_ = (unit_) >> 8; \
        const bf16_t* qb_ = Q + ((size_t)b_ * SEQ + blk_ * 128 + (pass_) * 64) * D + (g_ * 8 + wid) * 64 + ql_off; \
        _Pragma("unroll") for (int i_ = 0; i_ < 8; ++i_) \
            __builtin_amdgcn_global_load_lds((const unsigned*)(qb_ + (size_t)(8 * i_) * D), (LAS unsigned*)(lds + QOFF + wid * 8192 + i_ * 1024), 16, 0, 0); } while (0)
    int unit = bid, pass = 0, ch = 0, slot = 0;
    if (unit >= 512) { __syncthreads(); return; }
    ATT_STAGE(unit, 0, 0);
    ATT_STAGE_Q(unit, 0);
    VM_WAIT();
    __syncthreads();
    const short one_bf = (short)0x3F80; const bf16x8 ones = {one_bf, one_bf, one_bf, one_bf, one_bf, one_bf, one_bf, one_bf};
    f32x16 o[2][2], nm[2], la[2]; float mx[2]; bf16x8 qf[2][4];
    const float sk0 = sink[wid] * LOG2E, sk1 = sink[8 + wid] * LOG2E, sk2 = sink[16 + wid] * LOG2E, sk3 = sink[24 + wid] * LOG2E;
    for (;;) {
        const int g = unit & 3, blk = (unit >> 2) & 63, b = unit >> 8, hq = g * 8 + wid;
        int nunit = unit, npass = pass, nch = ch + 1;
        if (nch == 2 && blk == 0) nch = 3;
        if (nch == 4 && blk == 63) nch = 5;
        const bool last_ch = nch >= 5;
        if (last_ch) { nch = 0; npass = pass + 1; if (npass == 2) { npass = 0; nunit = unit + G; } }
        const bool has_next = nunit < 512;
        if (ch == 0) {
            const float sk = g == 0 ? sk0 : g == 1 ? sk1 : g == 2 ? sk2 : sk3;
#pragma unroll
            for (int t = 0; t < 2; ++t) {
#pragma unroll
                for (int d0 = 0; d0 < 4; ++d0) qf[t][d0] = *(const LAS bf16x8*)(lds + QOFF + wid * 8192 + (t * 32 + r32) * 128 + (((2 * d0 + hi) ^ (r32 & 7)) * 16));
#pragma unroll
                for (int db = 0; db < 2; ++db)
#pragma unroll
                    for (int r = 0; r < 16; ++r) o[t][db][r] = 0.f;
                mx[t] = sk;
#pragma unroll
                for (int r = 0; r < 16; ++r) { nm[t][r] = -sk; la[t][r] = 1.f; }
            }
            LDS_WAIT();
        }
        if (has_next) { ATT_STAGE(nunit, nch, slot ^ 1); if (nch == 0) ATT_STAGE_Q(nunit, npass); }
        const LAS unsigned char* ks = lds + slot * SLOTB; const LAS unsigned char* vs = ks + VOFF;
        for (int kt = 0; kt < (ATT_MODE == 1 ? 0 : 4); ++kt) {
            bf16x8 kf[4];
#pragma unroll
            for (int d0 = 0; d0 < 4; ++d0) kf[d0] = *(const LAS bf16x8*)(ks + (kt * 32 + r32) * 128 + (((2 * d0 + hi) ^ (r32 & 7)) * 16));
            bf16x8 vf[2][2];
#pragma unroll
            for (int db = 0; db < 2; ++db)
#pragma unroll
                for (int s = 0; s < 2; ++s) vf[db][s] = *(const LAS bf16x8*)(vs + (db * 32 + r32) * 256 + (((kt * 4 + 2 * s + hi) ^ (r32 & 15)) * 16));
#pragma unroll
            for (int t = 0; t < 2; ++t) {
                const int qt = pass * 2 + t;
                if ((ch == 2 && kt < qt) || (ch == 4 && kt > qt)) continue;
                if (__any(la[t][0] > 65536.f)) {
                    const float pc = la[t][0], dl = __builtin_amdgcn_logf(pc), al = __builtin_amdgcn_rcpf(pc);
                    mx[t] += dl;
#pragma unroll
                    for (int r = 0; r < 16; ++r) { nm[t][r] = -mx[t]; la[t][r] *= al; }
#pragma unroll
                    for (int db = 0; db < 2; ++db)
#pragma unroll
                        for (int r = 0; r < 16; ++r) o[t][db][r] *= al;
                }
                f32x16 sacc;
                asm volatile("s_nop 1\n\tv_mfma_f32_32x32x16_bf16 %0, %1, %2, %3" : "=&v"(sacc) : "v"(kf[0]), "v"(qf[t][0]), "v"(nm[t]));
#pragma unroll
                for (int d0 = 1; d0 < 4; ++d0) sacc = __builtin_amdgcn_mfma_f32_32x32x16_bf16(kf[d0], qf[t][d0], sacc, 0, 0, 0);
                if ((ch == 2 || ch == 4) && kt == qt) {
#pragma unroll
                    for (int r = 0; r < 16; ++r) { const int j = crow(r, hi); const bool ok = ch == 2 ? (j >= r32) : (j <= r32); if (!ok) sacc[r] = -1e30f; }
                }
#pragma unroll
                for (int r = 0; r < 16; ++r) sacc[r] = __builtin_amdgcn_exp2f(sacc[r]);
                u32x4 p0, p1;
                p0.x = cvt_pk_bf16(sacc[0], sacc[1]); p0.y = cvt_pk_bf16(sacc[2], sacc[3]); p0.z = cvt_pk_bf16(sacc[4], sacc[5]); p0.w = cvt_pk_bf16(sacc[6], sacc[7]);
                p1.x = cvt_pk_bf16(sacc[8], sacc[9]); p1.y = cvt_pk_bf16(sacc[10], sacc[11]); p1.z = cvt_pk_bf16(sacc[12], sacc[13]); p1.w = cvt_pk_bf16(sacc[14], sacc[15]);
                const bf16x8 pf0 = __builtin_bit_cast(bf16x8, p0), pf1 = __builtin_bit_cast(bf16x8, p1);
#pragma unroll
                for (int s = 0; s < 2; ++s) {
#pragma unroll
                    for (int db = 0; db < 2; ++db) o[t][db] = __builtin_amdgcn_mfma_f32_32x32x16_bf16(vf[db][s], s == 0 ? pf0 : pf1, o[t][db], 0, 0, 0);
                    la[t] = __builtin_amdgcn_mfma_f32_32x32x16_bf16(ones, s == 0 ? pf0 : pf1, la[t], 0, 0, 0);
                }
            }
        }
        VM_WAIT();
        if (last_ch && nostore) {
#pragma unroll
            for (int t = 0; t < 2; ++t) {
                asm volatile("" :: "v"(la[t][0]), "v"(mx[t]));
#pragma unroll
                for (int db = 0; db < 2; ++db)
#pragma unroll
                    for (int r = 0; r < 16; ++r) asm volatile("" :: "v"(o[t][db][r]));
            }
        }
        if (last_ch && ATT_MODE == 0 && !nostore) {
#pragma unroll
            for (int t = 0; t < 2; ++t) {
                const float inv = 1.f / la[t][0];
                const size_t row = (size_t)b * SEQ + blk * 128 + (pass * 2 + t) * 32 + r32;
                const int ocol = hq * 64 + 8 * hi;
#pragma unroll
                for (int db = 0; db < 2; ++db)
#pragma unroll
                    for (int k = 0; k < 2; ++k) {
                        const int ra = 8 * k, rb = 8 * k + 4;
                        const unsigned a0 = cvt_pk_bf16(o[t][db][ra] * inv, o[t][db][ra + 1] * inv), a1 = cvt_pk_bf16(o[t][db][ra + 2] * inv, o[t][db][ra + 3] * inv);
                        const unsigned b0 = cvt_pk_bf16(o[t][db][rb] * inv, o[t][db][rb + 1] * inv), b1 = cvt_pk_bf16(o[t][db][rb + 2] * inv, o[t][db][rb + 3] * inv);
                        const auto s0 = __builtin_amdgcn_permlane32_swap(a0, b0, false, false), s1 = __builtin_amdgcn_permlane32_swap(a1, b1, false, false);
                        u32x4 w; w.x = s0[0]; w.y = s1[0]; w.z = s0[1]; w.w = s1[1];
                        *(u32x4*)(O + hb_off((int)row, ocol + db * 32 + k * 16)) = w;
                    }
            }
        }
        __builtin_amdgcn_s_barrier();
        if (!has_next) break;
        unit = nunit; pass = npass; ch = nch; slot ^= 1;
    }
#undef ATT_STAGE
#undef ATT_STAGE_Q
}

constexpr int RING_BYTES = 131072, MISC_OFF = RING_BYTES + 320, LDS_BYTES = 147456;
constexpr int NPHASE = 24;

__global__ void __launch_bounds__(512, 2) fwd_kernel(Params P) {
    extern __shared__ __attribute__((aligned(16))) unsigned char lds_raw[];
    LAS unsigned char* lds = (LAS unsigned char*)lds_raw;
    volatile LAS unsigned* MISC = (volatile LAS unsigned*)(lds + MISC_OFF);
    const int tid = threadIdx.x, lane = tid & 63, wave = __builtin_amdgcn_readfirstlane(tid >> 6);
    const int G = gridDim.x, bid = blockIdx.x, gw = bid * 8 + wave, NGW = G * 8;
    unsigned char* ws = P.ws;
    if (tid < 64) MISC[tid] = 0u;
    __syncthreads();
    XcdBarrier bar = xcd_barrier_post((unsigned*)(ws + WS_CTL) + CW_BAR, MISC + 8);

    float* MOD = (float*)(ws + WS_MOD); const float* mod0 = MOD; const float* mod1 = MOD + 3 * NMODC;
    bf16_t* XB = (bf16_t*)(ws + WS_XB); bf16_t* YB = (bf16_t*)(ws + WS_YB); float* XC = (float*)(ws + WS_XC); bf16_t* HB = (bf16_t*)(ws + WS_HB);
    unsigned char* GR = ws + WS_GR; bf16_t* Gb = (bf16_t*)GR;
    bf16_t* GBb = (bf16_t*)(GR + GR_GB); bf16_t* VBb = (bf16_t*)(GR + GR_VB); bf16_t* PT1 = (bf16_t*)(GR + GR_PTQ); bf16_t* UFb = (bf16_t*)(GR + GR_UF); bf16_t* T1b = (bf16_t*)(ws + WS_T1); bf16_t* PTQC = (bf16_t*)(GR + GR_PTQC);
    bf16_t* Qb = (bf16_t*)(GR + GR_Q); bf16_t* KBb = (bf16_t*)(GR + GR_KB); bf16_t* VTb = (bf16_t*)(GR + GR_VT);
    const float* ropec = (const float*)(ws + WS_ROPE); const float* ropes = ropec + 2048;
    float* SLAB = (float*)(ws + WS_SLAB);
    constexpr size_t TS2K = (size_t)256 * 2048 * 2, TSFF = (size_t)256 * FF * 2;

    const int lo = P.ph_lo, hi = P.ph_hi;
#define IN(k) (lo <= (k) && (k) < hi)
#define SEAM(k) do { if (IN(k) && IN((k) + 1)) xcd_barrier(bar); } while (0)
#define GEMM1(idx, nM_) do { pg8::SchedSimple S; S.A = (const char*)HB; S.Bt = (const char*)(ws + WS_W1I + (size_t)(idx) * W1I_BYTES); S.tstep = TS2K; S.nM = (nM_); S.nN = 44; S.G = G; S.c = bid; \
        pg8::EpiSwiglu E{Gb}; pg8::gemm_phase<pg8::EpiSwiglu, pg8::SchedSimple, true, true>(lds, 2048, pg8::lay_blk(), S, E); } while (0)
#define GEMM2(idx, NP, gatep) do { typedef pg8::SchedRes<TSFF, NP> SR; SR S; S.A = (const char*)Gb; S.Bt = (const char*)(ws + WS_W2T + (size_t)(idx) * W2T_BYTES); S.G = G; S.c = bid; \
        pg8::EpiY E{YB, (gatep), 0.5f, (bf16_t*)SLAB}; pg8::gemm_phase<pg8::EpiY, SR, true, true>(lds, FF, pg8::lay_blk(), S, E); } while (0)
#define GEMMO(wsoff, NP, gatep) do { typedef pg8::SchedRes<TS2K, NP> SR; SR S; S.A = (const char*)HB; S.Bt = (const char*)(ws + (wsoff)); S.G = G; S.c = bid; \
        pg8::EpiY E{YB, (gatep), 1.0f, (bf16_t*)SLAB}; pg8::gemm_phase<pg8::EpiY, SR, true, true>(lds, 2048, pg8::lay_blk(), S, E); } while (0)
#define LNC(lni, modn_, ish_, nparts_, srcC_) ln_ctx_phase((srcC_), (const bf16_t*)SLAB, (nparts_), XC, HB, P.ln_g + (lni) * D, P.ln_b + (lni) * D, (modn_), (ish_), (LAS float*)lds, bid, G, tid, lane, wave)

    if (IN(0)) { p0_prologue(P, lds, tid, lane, wave, bid, G); }
    SEAM(0);
    if (IN(1)) { if (NGW * 4 == SEQ) h0b_phase(P.x, P.ctx, mod0, HB, gw, NGW, lane); else h0_phase(P.x, P.ctx, mod0, HB, gw, NGW, lane); }
    SEAM(1);
    if (IN(2)) { GEMM1(0, NPT);
        if (bid >= 88) { LAS float* scr = (LAS float*)(lds + wave * 16384); const int sl = (bid - 88) * 8 + wave, ns = (G - 88) * 8;
            copy_range(P, scr, 2 * CP_MAT, 3 * CP_MAT, sl, ns, lane); copy_range(P, scr, CP_OTH0, CP_OTH1, sl, ns, lane); } }
    SEAM(2);
    if (IN(3)) { GEMM2(0, 11, mod0 + 2 * D); }
    SEAM(3);
    if (IN(4)) { if (NGW * 4 == SEQ) ln3_phase<true, false>(P.x, YB, XB, HB, P.ln_g, P.ln_b, mod0, 3, gw, NGW, lane); else ln2_phase<true, false>(P.x, YB, XB, HB, P.ln_g, P.ln_b, mod0, 3, gw, NGW, lane); LNC(0, mod0, 3, 11, P.ctx); }
    SEAM(4);
    if (IN(5)) { { pg8::SchedSimple S; S.A = (const char*)HB; S.Bt = (const char*)(ws + WS_WMI); S.tstep = TS2K; S.nM = NPT; S.nN = 16; S.G = G; S.c = bid;
          pg8::EpiMixIn E{GBb, VBb, UFb}; pg8::gemm_phase<pg8::EpiMixIn, pg8::SchedSimple, true, true>(lds, 2048, pg8::lay_blk(), S, E); }
        if (bid >= 32) { copy_range(P, (LAS float*)(lds + wave * 16384), 3 * CP_MAT, 6 * CP_MAT, (bid - 32) * 8 + wave, (G - 32) * 8, lane); } }
    SEAM(5);
    if (IN(6)) { { pg8::SchedCh S; S.CH = (const char*)(ws + WS_CH); S.UF = (const char*)UFb; S.G = G; S.c = bid;
          pg8::Lay L = pg8::lay_rm(1024); L.hstepB = 4 * 1024 * 2;
          pg8::EpiCh E{PT1}; pg8::gemm_phase<pg8::EpiCh, pg8::SchedCh, true, true>(lds, 256 + pg8::opaque0(), L, S, E); } }
    SEAM(6);
    if (IN(7)) { { pg8::SchedF1 S; S.A1 = (const char*)(ws + WS_A1); S.PT1 = (const char*)PT1; S.G = G; S.c = bid;
          pg8::EpiF1 E{T1b}; pg8::gemm_phase<pg8::EpiF1, pg8::SchedF1, true, true>(lds, 256 + pg8::opaque0(), pg8::lay_rm(256), S, E); }
        { pg8::SchedChC S; S.CH = (const char*)(ws + WS_CH); S.UF = (const char*)UFb; S.G = G; S.c = bid;
          pg8::EpiChC E{PTQC}; pg8::gemm_phase<pg8::EpiChC, pg8::SchedChC, true, true>(lds, 256 + pg8::opaque0(), pg8::lay_rm(1024), S, E); } }
    SEAM(7);
    if (IN(8)) { { pg8::SchedF2 S; S.A2M = (const char*)(ws + WS_A2M); S.T1 = (const char*)T1b; S.G = G; S.c = bid;
          pg8::EpiF2 E{HB, 1.f / 1024.f}; pg8::gemm_phase<pg8::EpiF2, pg8::SchedF2, true, true>(lds, 512 + pg8::opaque0(), pg8::lay_rm(512), S, E); }
        { pg8::SchedDftC S; S.ACTX = (const char*)(ws + WS_ACTX); S.PTQC = (const char*)PTQC; S.tstep = (size_t)256 * 512 * 2; S.G = G; S.c = bid;
          pg8::EpiDft E{HB, 0.00552427172802f}; pg8::gemm_phase<pg8::EpiDft, pg8::SchedDftC, true, true>(lds, 512 + pg8::opaque0(), pg8::lay_rm(512), S, E); }
        conv_phase(GBb, VBb, P.ab_conv, HB, gw, NGW, lane); }
    SEAM(8);
    if (IN(9)) { GEMMO(WS_WMO, 4, mod0 + 5 * D); }
    SEAM(9);
#if PROBE == 100 || PROBE == 101
    if (IN(10)) { for (int rep = 0; rep < 5 + pg8::opaque0(); ++rep) { if (rep) xcd_barrier(bar);
        bf16_t* xd = rep ? (bf16_t*)(ws + WS_T1) : (bf16_t*)XB; bf16_t* hd = rep ? (bf16_t*)(ws + WS_GR) : HB;
        if (PROBE == 101) ln3_phase<false, false>(XB, YB, xd, hd, P.ln_g + D, P.ln_b + D, mod0, 6, gw, NGW, lane);
        else ln2_phase<false, false>(XB, YB, xd, hd, P.ln_g + D, P.ln_b + D, mod0, 6, gw, NGW, lane); }
#else
    if (IN(10)) { if (NGW * 4 == SEQ) ln3_phase<false, false>(XB, YB, XB, HB, P.ln_g + D, P.ln_b + D, mod0, 6, gw, NGW, lane); else ln2_phase<false, false>(XB, YB, XB, HB, P.ln_g + D, P.ln_b + D, mod0, 6, gw, NGW, lane);
#endif
 LNC(1, mod0, 6, 4, XC); }
    SEAM(10);
    if (IN(11)) { GEMM1(1, NPT);
        if (bid >= 88) { LAS float* scr = (LAS float*)(lds + wave * 16384); const int sl = (bid - 88) * 8 + wave, ns = (G - 88) * 8;
            copy_range(P, scr, 6 * CP_MAT, 8 * CP_MAT, sl, ns, lane); } }
    SEAM(11);
    if (IN(12)) { GEMM2(1, 11, mod0 + 8 * D); }
    SEAM(12);
    if (IN(13)) { if (NGW * 4 == SEQ) ln3_phase<false, false>(XB, YB, XB, HB, P.ln_g + 2 * D, P.ln_b + 2 * D, mod1, 0, gw, NGW, lane); else ln2_phase<false, false>(XB, YB, XB, HB, P.ln_g + 2 * D, P.ln_b + 2 * D, mod1, 0, gw, NGW, lane); LNC(2, mod1, 0, 11, XC); }
    SEAM(13);
    if (IN(14)) { GEMM1(2, NPT);
        if (bid >= 88) { LAS float* scr = (LAS float*)(lds + wave * 16384); const int sl = (bid - 88) * 8 + wave, ns = (G - 88) * 8;
            copy_range(P, scr, 8 * CP_MAT, 9 * CP_MAT, sl, ns, lane); copy_range(P, scr, CP_OTH1, CP_NITEMS, sl, ns, lane); } }
    SEAM(14);
    if (IN(15)) { GEMM2(2, 11, mod1 + 2 * D); }
    SEAM(15);
    if (IN(16)) { if (NGW * 4 == SEQ) ln3_phase<false, false>(XB, YB, XB, HB, P.ln_g + 3 * D, P.ln_b + 3 * D, mod1, 3, gw, NGW, lane); else ln2_phase<false, false>(XB, YB, XB, HB, P.ln_g + 3 * D, P.ln_b + 3 * D, mod1, 3, gw, NGW, lane); LNC(3, mod1, 3, 11, XC); }
    SEAM(16);
    if (IN(17)) { { pg8::SchedAttnIn S; S.HB = (const char*)HB; S.WQKV = (const char*)(ws + WS_WQKV); S.tstep = TS2K; S.G = G; S.c = bid;
          pg8::EpiAttnIn E{Qb, KBb, VTb, ropec, ropes}; pg8::gemm_phase<pg8::EpiAttnIn, pg8::SchedAttnIn, true, true>(lds, 2048, pg8::lay_blk(), S, E); }
          if (bid >= 132) { copy_range(P, (LAS float*)(lds + wave * 16384), 9 * CP_MAT, 10 * CP_MAT, (bid - 132) * 8 + wave, (G - 132) * 8, lane); } }
    SEAM(17);
#if PROBE == 180 || PROBE == 181
    if (IN(18)) { for (int rep = 0; rep < 5 + pg8::opaque0(); ++rep) { if (rep) xcd_barrier(bar); attn_phase(lds, Qb, KBb, VTb, P.at_sink, HB, bid, G, tid, PROBE == 181 && rep > 0); } }
#else
    if (IN(18)) { attn_phase(lds, Qb, KBb, VTb, P.at_sink, HB, bid, G, tid); }
#endif
#if PROBE > 180 && PROBE < 200
    if (IN(18)) { for (int rep = 0; rep < 4 + pg8::opaque0(); ++rep) { xcd_barrier(bar); attn_phase<PROBE >= 190 ? PROBE - 190 : 0>(lds, Qb, KBb, VTb, P.at_sink, HB, bid, G, tid); } }
#endif
    SEAM(18);
    if (IN(19)) { GEMMO(WS_WO, 0, mod1 + 5 * D); }
    SEAM(19);
    if (IN(20)) { if (NGW * 4 == SEQ) ln3_phase<false, false>(XB, YB, XB, HB, P.ln_g + 4 * D, P.ln_b + 4 * D, mod1, 6, gw, NGW, lane); else ln2_phase<false, false>(XB, YB, XB, HB, P.ln_g + 4 * D, P.ln_b + 4 * D, mod1, 6, gw, NGW, lane); }
    SEAM(20);
    if (IN(21)) { GEMM1(3, NPL);
        if (bid >= 128) { copy_range(P, (LAS float*)(lds + wave * 16384), 11 * CP_MAT, 12 * CP_MAT, (bid - 128) * 8 + wave, (G - 128) * 8, lane); } }
    SEAM(21);
    if (IN(22)) { GEMM2(3, 0, mod1 + 8 * D); }
    SEAM(22);
    if (IN(23)) { if (NGW * 4 == SEQ) ln3_phase<false, true>(XB, YB, P.out, (bf16_t*)nullptr, P.ln_g + 5 * D, P.ln_b + 5 * D, mod1, 0, gw, NGW, lane); else ln2_phase<false, true>(XB, YB, P.out, (bf16_t*)nullptr, P.ln_g + 5 * D, P.ln_b + 5 * D, mod1, 0, gw, NGW, lane); }
#undef IN
#undef SEAM
#undef GEMM1
#undef GEMM2
#undef GEMMO
#undef LNC
}

extern "C" void kernel_launch(void* const* d_in, const int* in_sizes, int n_in, void* d_out, int out_size, void* d_ws, size_t ws_size, hipStream_t stream) {
    static int grid = 0;
    if (grid == 0) {
        if (n_in != 17 || ws_size < WS_END) { fprintf(stderr, "kernel_launch: n_in %d ws %zu (need %zu)\n", n_in, ws_size, (size_t)WS_END); grid = -1; return; }
        int dev = 0, cus = 0, per_cu = 0;
        if (hipGetDevice(&dev) != hipSuccess || hipDeviceGetAttribute(&cus, hipDeviceAttributeMultiprocessorCount, dev) != hipSuccess) { grid = -1; return; }
        if (hipFuncSetAttribute((const void*)fwd_kernel, hipFuncAttributeMaxDynamicSharedMemorySize, LDS_BYTES) != hipSuccess) { fprintf(stderr, "kernel_launch: hipFuncSetAttribute failed\n"); grid = -1; return; }
        if (hipOccupancyMaxActiveBlocksPerMultiprocessor(&per_cu, (const void*)fwd_kernel, 512, LDS_BYTES) != hipSuccess || per_cu < 1) { fprintf(stderr, "kernel_launch: occupancy query says %d\n", per_cu); }
        (void)hipGetLastError();
        grid = cus;
    }
    if (grid < 0) return;
    if (hipMemsetAsync((char*)d_ws + WS_CTL, 0, CTL_ZERO_BYTES, stream) != hipSuccess) return;
    Params p{};
    p.x = (const float*)d_in[0]; p.c = (const float*)d_in[1]; p.ctx = (const float*)d_in[2]; p.c_ctx = (const float*)d_in[3]; p.w_mod = (const float*)d_in[4]; p.b_mod = (const float*)d_in[5];
    p.ln_g = (const float*)d_in[6]; p.ln_b = (const float*)d_in[7]; p.wg = (const float*)d_in[8]; p.wu = (const float*)d_in[9]; p.wd = (const float*)d_in[10];
    p.ab_in = (const float*)d_in[11]; p.ab_conv = (const float*)d_in[12]; p.ab_out = (const float*)d_in[13]; p.at_in = (const float*)d_in[14]; p.at_sink = (const float*)d_in[15]; p.at_out = (const float*)d_in[16];
    p.out = (float*)d_out; p.ws = (unsigned char*)d_ws; p.ph_lo = 0; p.ph_hi = NPHASE;
    hipLaunchKernelGGL(fwd_kernel, dim3(grid), dim3(512), LDS_BYTES, stream, p);
}
```
